# Optimizing an MI355X kernel written in HIP

```python
import math
import jax, jax.numpy as jnp
from jax import lax
import numpy as np


D_MODEL = 1024
BATCH = 2
SEQ = 8192
DEPTH = 1

CHUNK = 64
QBLK = 128
EPS = 1e-6
NEG = -1e30

SSM_WIDTH = D_MODEL
SSM_GROUP = 16
SSM_GROUPS = SSM_WIDTH // SSM_GROUP
SSM_STATE = 64
DT_MIN = 1e-3
DT_MAX = 1e-1

N_HEADS = 8
HEAD_DIM = 128
N_KV_HEADS = 2
Q_PER_KV = N_HEADS // N_KV_HEADS
ATT_WIDTH = N_HEADS * HEAD_DIM
KV_WIDTH = N_KV_HEADS * HEAD_DIM
IDX_HEADS = 16
IDX_DIM = 64
TOPK_MAX = 256
ROPE_THETA = 500000.0
ATT_ROT = HEAD_DIM // 4
IDX_ROT = IDX_DIM // 4

FFN_HIDDEN = -(-8 * D_MODEL // (3 * 256)) * 256

SPLIT_SIZES = (SSM_WIDTH, ATT_WIDTH, KV_WIDTH, KV_WIDTH, IDX_HEADS * IDX_DIM, IDX_DIM, IDX_HEADS, D_MODEL, D_MODEL)
IN_WIDTH = SSM_WIDTH + ATT_WIDTH + 2 * KV_WIDTH + IDX_HEADS * IDX_DIM + IDX_DIM + IDX_HEADS + 2 * D_MODEL

kernel_name = 'hybrid_s5_dsa_gated_block'


def _split_points():
    pts, acc = [], 0
    for s in SPLIT_SIZES[:-1]:
        acc += s
        pts.append(acc)
    return pts


def _rmsnorm(x, g):
    xf = x.astype(jnp.float32)
    y = xf * lax.rsqrt(jnp.mean(xf * xf, axis=-1, keepdims=True) + EPS)
    return (y * g.astype(jnp.float32)).astype(x.dtype)


def _rope_partial(x, pos, rot_dim):
    half = rot_dim // 2
    inv_freq = ROPE_THETA ** (-jnp.arange(half, dtype=jnp.float32) / half)
    ang = pos.astype(jnp.float32)[:, None] * inv_freq[None, :]
    cos = jnp.cos(ang)[:, None, :]
    sin = jnp.sin(ang)[:, None, :]
    xr = x[..., :rot_dim].astype(jnp.float32)
    x1, x2 = xr[..., :half], xr[..., half:]
    rot = jnp.concatenate([x1 * cos - x2 * sin, x1 * sin + x2 * cos], axis=-1).astype(x.dtype)
    return jnp.concatenate([rot, x[..., rot_dim:]], axis=-1)


def _s5_branch(u, a_re, a_im, log_dt, b_re, b_im, c_re, c_im, d_skip, w_glu):
    bsz, L, _ = u.shape
    f32 = jnp.float32
    uf = u.astype(f32).reshape(bsz, L, SSM_GROUPS, SSM_GROUP)
    dt = jnp.exp(log_dt.astype(f32))[:, None]
    ar = a_re.astype(f32)
    ai = a_im.astype(f32)
    mag = jnp.exp(ar * dt)
    lb_re = mag * jnp.cos(ai * dt)
    lb_im = mag * jnp.sin(ai * dt)
    num_re = lb_re - 1.0
    num_im = lb_im
    den = ar * ar + ai * ai
    f_re = (num_re * ar + num_im * ai) / den
    f_im = (num_im * ar - num_re * ai) / den
    bu_re = jnp.einsum('blgc,gpc->lbgp', uf, b_re.astype(f32))
    bu_im = jnp.einsum('blgc,gpc->lbgp', uf, b_im.astype(f32))
    x_re = f_re * bu_re - f_im * bu_im
    x_im = f_re * bu_im + f_im * bu_re
    shp = (L, 1, SSM_GROUPS, SSM_STATE)
    a_s_re = jnp.broadcast_to(lb_re, shp)
    a_s_im = jnp.broadcast_to(lb_im, shp)

    def combine(e1, e2):
        a1r, a1i, b1r, b1i = e1
        a2r, a2i, b2r, b2i = e2
        return (a2r * a1r - a2i * a1i,
                a2r * a1i + a2i * a1r,
                a2r * b1r - a2i * b1i + b2r,
                a2r * b1i + a2i * b1r + b2i)

    _, _, h_re, h_im = lax.associative_scan(combine, (a_s_re, a_s_im, x_re, x_im), axis=0)
    y = (jnp.einsum('lbgp,gcp->blgc', h_re, c_re.astype(f32))
         - jnp.einsum('lbgp,gcp->blgc', h_im, c_im.astype(f32))
         + d_skip.astype(f32) * uf)
    y = jax.nn.gelu(y.reshape(bsz, L, SSM_WIDTH))
    y = y * jax.nn.sigmoid(y @ w_glu.astype(f32))
    return y.astype(u.dtype)


def _dsa_branch(q, k, v, qi, ki, wi, pos):
    bsz, L, _ = q.shape
    f32 = jnp.float32
    k_sel = min(TOPK_MAX, L // 4)
    nblk = L // QBLK
    q = _rope_partial(q.reshape(bsz, L, N_HEADS, HEAD_DIM), pos, ATT_ROT)
    k = _rope_partial(k.reshape(bsz, L, N_KV_HEADS, HEAD_DIM), pos, ATT_ROT)
    v = v.reshape(bsz, L, N_KV_HEADS, HEAD_DIM)
    qi = _rope_partial(qi.reshape(bsz, L, IDX_HEADS, IDX_DIM), pos, IDX_ROT)
    ki = _rope_partial(ki.reshape(bsz, L, 1, IDX_DIM), pos, IDX_ROT)[:, :, 0].astype(f32)
    key_chunk = pos // CHUNK

    def to_blocks(a):
        return jnp.moveaxis(a.reshape((bsz, nblk, QBLK) + a.shape[2:]), 1, 0)

    def block_fn(args):
        qb, qib, wb, qpos = args
        rel = jnp.einsum('bqhd,bsd->bqhs', qib.astype(f32), ki) * (IDX_DIM ** -0.5)
        score = jnp.einsum('bqhs,bqh->bqs', jax.nn.relu(rel), wb.astype(f32) * (IDX_HEADS ** -0.5))
        allowed = key_chunk[None, :] <= (qpos // CHUNK)[:, None]
        score = jnp.where(allowed[None], score, NEG)
        top_val, top_idx = lax.top_k(score, k_sel)
        valid = top_val > 0.5 * NEG
        kg = jax.vmap(lambda kk, ii: kk[ii])(k, top_idx)
        vg = jax.vmap(lambda vv, ii: vv[ii])(v, top_idx)
        qg = qb.reshape(bsz, QBLK, N_KV_HEADS, Q_PER_KV, HEAD_DIM)
        s = jnp.einsum('bqgrd,bqkgd->bqgrk', qg, kg).astype(f32) * (HEAD_DIM ** -0.5)
        s = jnp.where(valid[:, :, None, None, :], s, NEG)
        p = jax.nn.softmax(s, axis=-1).astype(v.dtype)
        o = jnp.einsum('bqgrk,bqkgd->bqgrd', p, vg)
        return o.reshape(bsz, QBLK, ATT_WIDTH)

    out = lax.map(block_fn, (to_blocks(q), to_blocks(qi), to_blocks(wi), pos.reshape(nblk, QBLK)))
    return jnp.moveaxis(out, 0, 1).reshape(bsz, L, ATT_WIDTH)


def setup_inputs(seed: int = 0) -> dict:
    key = jax.random.key(seed)
    ks = jax.random.split(key, 19)
    f32 = jnp.float32
    G, P, C = SSM_GROUPS, SSM_STATE, SSM_GROUP

    def nrm(k, shape, scale):
        return jax.random.normal(k, shape, f32) * scale

    x = nrm(ks[0], (BATCH, SEQ, D_MODEL), 1.0)
    norm1_g = 1.0 + nrm(ks[1], (DEPTH, D_MODEL), 0.02)
    w_in = nrm(ks[2], (DEPTH, D_MODEL, IN_WIDTH), D_MODEL ** -0.5)
    a_re = -0.5 * jnp.exp(nrm(ks[3], (DEPTH, G, P), 0.02))
    a_im = math.pi * jnp.arange(P, dtype=f32) + nrm(ks[4], (DEPTH, G, P), 0.02)
    log_dt = jax.random.uniform(ks[5], (DEPTH, G), f32, math.log(DT_MIN), math.log(DT_MAX))
    b_re = nrm(ks[6], (DEPTH, G, P, C), (2 * C) ** -0.5)
    b_im = nrm(ks[7], (DEPTH, G, P, C), (2 * C) ** -0.5)
    c_re = nrm(ks[8], (DEPTH, G, C, P), P ** -0.5)
    c_im = nrm(ks[9], (DEPTH, G, C, P), P ** -0.5)
    d_skip = nrm(ks[10], (DEPTH, G, C), 1.0)
    w_glu = nrm(ks[11], (DEPTH, SSM_WIDTH, SSM_WIDTH), SSM_WIDTH ** -0.5)
    w_branch_a = nrm(ks[12], (DEPTH, SSM_WIDTH, D_MODEL), SSM_WIDTH ** -0.5)
    w_branch_b = nrm(ks[13], (DEPTH, ATT_WIDTH, D_MODEL), ATT_WIDTH ** -0.5)
    w_out = nrm(ks[14], (DEPTH, D_MODEL, D_MODEL), D_MODEL ** -0.5)
    norm2_g = 1.0 + nrm(ks[15], (DEPTH, D_MODEL), 0.02)
    w_ffn_in = nrm(ks[16], (DEPTH, D_MODEL, 2 * FFN_HIDDEN), D_MODEL ** -0.5)
    w_ffn_out = nrm(ks[17], (DEPTH, FFN_HIDDEN, D_MODEL), FFN_HIDDEN ** -0.5)
    norm_f_g = 1.0 + nrm(ks[18], (D_MODEL,), 0.02)
    return {'x': x, 'norm1_g': norm1_g, 'w_in': w_in, 'a_re': a_re, 'a_im': a_im, 'log_dt': log_dt,
            'b_re': b_re, 'b_im': b_im, 'c_re': c_re, 'c_im': c_im, 'd_skip': d_skip, 'w_glu': w_glu,
            'w_branch_a': w_branch_a, 'w_branch_b': w_branch_b, 'w_out': w_out, 'norm2_g': norm2_g,
            'w_ffn_in': w_ffn_in, 'w_ffn_out': w_ffn_out, 'norm_f_g': norm_f_g}


def reference(x, norm1_g, w_in, a_re, a_im, log_dt, b_re, b_im, c_re, c_im, d_skip, w_glu,
              w_branch_a, w_branch_b, w_out, norm2_g, w_ffn_in, w_ffn_out, norm_f_g):
    L = x.shape[1]
    pos = jnp.arange(L, dtype=jnp.int32)
    split_pts = _split_points()
    for i in range(DEPTH):
        h = _rmsnorm(x, norm1_g[i])
        proj = h @ w_in[i]
        u, q, k, v, qi, ki, wi, ga, gb = jnp.split(proj, split_pts, axis=-1)
        ya = _s5_branch(u, a_re[i], a_im[i], log_dt[i], b_re[i], b_im[i], c_re[i], c_im[i], d_skip[i], w_glu[i])
        yb = _dsa_branch(q, k, v, qi, ki, wi, pos)
        merged = jax.nn.sigmoid(ga) * (ya @ w_branch_a[i]) + jax.nn.sigmoid(gb) * (yb @ w_branch_b[i])
        x = x + merged @ w_out[i]
        h2 = _rmsnorm(x, norm2_g[i])
        g, up = jnp.split(h2 @ w_ffn_in[i], [FFN_HIDDEN], axis=-1)
        x = x + (jax.nn.silu(g) * up) @ w_ffn_out[i]
    return _rmsnorm(x, norm_f_g)
```

```cpp
#include <hip/hip_runtime.h>
#include <cstdio>
#include <cstdint>
typedef _Float16 h16;
typedef _Float16 h16x8 __attribute__((ext_vector_type(8)));
typedef float f32x4 __attribute__((ext_vector_type(4)));
typedef unsigned u32x4 __attribute__((ext_vector_type(4)));
#define LAS __attribute__((address_space(3)))
#define CAS __attribute__((address_space(4)))

constexpr int BATCH = 2, SEQ = 8192, DM = 1024, M = BATCH * SEQ;
constexpr int NG = 64, GC = 16, NP = 64;
constexpr int NH = 8, HD = 128, NKV = 2, KVW = 256;
constexpr int IH = 16, IDIM = 64;
constexpr int TOPK = 256, CH = 64, NCH = SEQ / CH;
constexpr int FF = 2816;
constexpr int INW = 5712;
constexpr float EPS = 1e-6f;
constexpr float LN_THETA = 13.122363377404328f;
constexpr int C_U = 0, C_Q = 1024, C_K = 2048, C_V = 2304, C_QI = 2560, C_KI = 3584, C_WI = 3648, C_GA = 3664, C_GB = 4688;
constexpr int NWIN = 3840;

constexpr size_t MiB = 1u << 20;
constexpr size_t WS_CTL = 0, WS_TAB = 1 * MiB;
constexpr size_t WS_K = 3 * MiB, WS_V = 11 * MiB, WS_QI = 19 * MiB, WS_KI = 51 * MiB, WS_WI = 53 * MiB, WS_IDX = 54 * MiB;
constexpr size_t WS_H = 62 * MiB;
constexpr size_t WS_SC = 94 * MiB;
constexpr size_t WS_U = 94 * MiB, WS_YS = 134 * MiB, WS_WIN = 134 * MiB, WS_BTM = 166 * MiB, WS_BTS = 206 * MiB;
constexpr size_t WS_YB = 94 * MiB, WS_SA = 126 * MiB, WS_SB = 158 * MiB, WS_MG = 190 * MiB;
constexpr size_t WS_HID = 94 * MiB;
constexpr size_t WS_WGA = 223 * MiB, WS_WGB = 225 * MiB, WS_WA = 227 * MiB, WS_WB = 229 * MiB, WS_WGLU = 231 * MiB,     WS_WOUT = 233 * MiB, WS_WFI = 235 * MiB, WS_WFO = 246 * MiB;
constexpr size_t WS_SSQ = 252 * MiB, WS_END = 254 * MiB;
constexpr size_t SC_BATCH = (size_t)4096 * 8256;
constexpr int LDS_BYTES = 147456;

struct Params {
    const float *x, *norm1_g, *w_in, *a_re, *a_im, *log_dt, *b_re, *b_im, *c_re, *c_im, *d_skip, *w_glu, *w_a, *w_b, *w_out, *norm2_g, *w_ffn_in, *w_ffn_out, *norm_f_g;
    float* out; unsigned char* ws;
};

__device__ __forceinline__ float wave_sum(float v) {
#pragma unroll
    for (int o = 1; o < 64; o <<= 1) v += __shfl_xor(v, o);
    return v;
}
__device__ __forceinline__ float wave_max(float v) {
#pragma unroll
    for (int o = 1; o < 64; o <<= 1) v = fmaxf(v, __shfl_xor(v, o));
    return v;
}
__device__ __forceinline__ float sigmoidf_(float v) { return __builtin_amdgcn_rcpf(1.f + __expf(-v)); }
__device__ __forceinline__ float gelu_tanh(float v) {
    const float u2 = 1.5957691216057308f * (v + 0.044715f * v * v * v);
    return v * __builtin_amdgcn_rcpf(1.f + __expf(-u2));
}
__device__ __forceinline__ void sincos_big(float ang, float& s, float& c) {
    const double a = (double)ang;
    const double n = __builtin_rint(a * 0.15915494309189535);
    const float r = (float)(a - n * 6.283185307179586);
    s = __sinf(r); c = __cosf(r);
}
__device__ __forceinline__ unsigned pk2h(float lo, float hi) { return __builtin_bit_cast(unsigned, __builtin_amdgcn_cvt_pkrtz(lo, hi)); }
__device__ __forceinline__ u32x4 pack8(f32x4 a, f32x4 b) { u32x4 w; w.x = pk2h(a[0], a[1]); w.y = pk2h(a[2], a[3]); w.z = pk2h(b[0], b[1]); w.w = pk2h(b[2], b[3]); return w; }

namespace pg8 {
constexpr int BM = 256, BK = 64, HALF = 128, HTB = HALF * BK * 2, STAGE_BYTES = 8 * HTB, NXCD = 8, WGM = 8;
__host__ __device__ __forceinline__ int lds_byte(int r, int c) { const int st = (r >> 4) * 2 + (c >> 5), rr = r & 15, cc = c & 31, ob = rr * 64 + cc * 2; return st * 1024 + (ob ^ (((ob >> 9) & 1) << 5)); }
__host__ __device__ __forceinline__ void stage_rc(int b, int& R, int& C) { const int st = b / 1024, sb = b % 1024, swz = sb ^ (((sb >> 9) & 1) << 5); R = (st >> 1) * 16 + swz / 64; C = (st & 1) * 32 + (swz % 64) / 2; }
__host__ __device__ __forceinline__ int perm32(int rho) { const int n = rho >> 4, i = rho & 15; return 8 * (i >> 2) + 4 * n + (i & 3); }

struct Unit { const char* A; const char* B; int pm, pn, tag; };
struct StaticOrder {
    int nM, nN, nwg, G, c;
    __host__ __device__ __forceinline__ void init(int Mr, int N, int G_, int c_) { nM = Mr / BM; nN = N / BM; nwg = nM * nN; G = G_; c = c_; }
    __host__ __device__ __forceinline__ bool next(int i, int& pm, int& pn) const {
        const long L = (long)i * G + c; if (L >= nwg) return false;
        int wgid = (int)L; { const int q = nwg / NXCD, r = nwg % NXCD, xcd = wgid % NXCD, off = wgid / NXCD; wgid = (xcd < r ? xcd * (q + 1) : r * (q + 1) + (xcd - r) * q) + off; }
        const int nig = WGM * nN, gid = wgid / nig, fm = gid * WGM, gsz = (nM - fm) < WGM ? (nM - fm) : WGM;
        pm = fm + ((wgid % nig) % gsz); pn = (wgid % nig) / gsz; return true;
    }
};
struct SchedStd {
    StaticOrder so; const char* A; const char* B; size_t tstepA, tstepB;
    __device__ __forceinline__ bool next(int i, Unit& u) const { int pm, pn; if (!so.next(i, pm, pn)) return false; u.A = A + (size_t)pm * tstepA; u.B = B + (size_t)pn * tstepB; u.pm = pm; u.pn = pn; u.tag = i; return true; }
};
struct SchedSeg4 {
    int pm, pn; bool ok; const char* aH; long dYA, dYB; const char* bW; long bstep;
    __device__ __forceinline__ bool next(int i, Unit& u) const {
        if (!ok || i >= 4) return false;
        u.A = aH + (i == 2 ? dYA : 0l) + (i == 3 ? dYB : 0l); u.B = bW + (long)i * bstep; u.pm = pm; u.pn = pn; u.tag = i; return true;
    }
};
struct Geo { int lda, ldb, nt; };

template <class Epi, class Sched>
__device__ __forceinline__ void gemm_phase(LAS unsigned char* lds, const Geo G, const Sched& S, const Epi& E) {
    int tid_ = threadIdx.x; asm volatile("" : "+v"(tid_));
    const int tid = tid_, wid = __builtin_amdgcn_readfirstlane(tid >> 6), lane = tid & 63, wr = wid >> 2, wc = wid & 3, fr = lane & 15, fq = lane >> 4;
    const int nt = G.nt;
    unsigned voffA[2], voffB[2];
#pragma unroll
    for (int i = 0; i < 2; ++i) { int R, C; stage_rc(tid * 16 + i * 8192, R, C); const int Rb = (R & ~31) + perm32(R & 31);
        voffA[i] = (unsigned)(R * G.lda + C) * 2u; voffB[i] = (unsigned)(Rb * G.ldb + C) * 2u; }
    const size_t kstep = (size_t)(BK * 2);
    const size_t hstepA = (size_t)HALF * G.lda * 2, hstepB = (size_t)HALF * G.ldb * 2;
    const unsigned ldsw = (unsigned)wid * 1024u;
    const int aoff = lds_byte(wr * 64 + fr, fq * 8), boff = lds_byte(wc * 32 + fr, fq * 8);
#define PG8_SA(b, h) (((b) * 2 + (h)) * HTB)
#define PG8_SB(b, h) ((4 + (b) * 2 + (h)) * HTB)
#define PG8_STAGE(bufoff, gbase, voff) do { _Pragma("unroll") for (int _i = 0; _i < 2; ++_i) { unsigned vo_ = (voff)[_i]; asm volatile("" : "+v"(vo_));     \
        __builtin_amdgcn_global_load_lds((const unsigned*)((const char*)(gbase) + vo_), (LAS unsigned*)(lds + (bufoff) + ldsw + _i * 8192), 16, 0, 0); } } while (0)
#define PG8_LDA(dst, b, h) do { _Pragma("unroll") for (int m = 0; m < 4; ++m) _Pragma("unroll") for (int k = 0; k < 2; ++k) dst[m][k] = *(const LAS h16x8*)(lds + PG8_SA(b, h) + aoff + m * 2048 + k * 1024); } while (0)
#define PG8_LDB(dst, b, h) do { _Pragma("unroll") for (int n = 0; n < 2; ++n) _Pragma("unroll") for (int k = 0; k < 2; ++k) dst[n][k] = *(const LAS h16x8*)(lds + PG8_SB(b, h) + boff + n * 2048 + k * 1024); } while (0)
#define PG8_MMA(ai, bj, At, Bt) do { __builtin_amdgcn_s_setprio(1); _Pragma("unroll") for (int m = 0; m < 4; ++m) _Pragma("unroll") for (int n = 0; n < 2; ++n) _Pragma("unroll") for (int k = 0; k < 2; ++k) \
        acc[ai][bj][m][n] = __builtin_amdgcn_mfma_f32_16x16x32_f16(Bt[n][k], At[m][k], acc[ai][bj][m][n], 0, 0, 0); __builtin_amdgcn_s_setprio(0); } while (0)
#define PG8_WAIT_V(n) asm volatile("s_waitcnt vmcnt(" #n ")" ::: "memory")
#define PG8_WAIT_L(n) asm volatile("s_waitcnt lgkmcnt(" #n ")" ::: "memory")
#define PG8_BAR __builtin_amdgcn_s_barrier()
#define PG8_SCHED __builtin_amdgcn_sched_barrier(0)
#define PG8_ZERO() do { _Pragma("unroll") for (int a = 0; a < 2; ++a) _Pragma("unroll") for (int b = 0; b < 2; ++b) _Pragma("unroll") for (int m = 0; m < 4; ++m) _Pragma("unroll") for (int n = 0; n < 2; ++n) acc[a][b][m][n] = (f32x4){0.f, 0.f, 0.f, 0.f}; } while (0)
    Unit cur, nxt; int ui = 0;
    if (!S.next(0, cur)) return;
    f32x4 acc[2][2][4][2];
    PG8_ZERO();
    h16x8 At[4][2], B0[2][2], B1[2][2];
    const char* cA = cur.A; const char* cB = cur.B;
    PG8_STAGE(PG8_SB(0, 0), cB, voffB); PG8_STAGE(PG8_SB(0, 1), cB + hstepB, voffB); PG8_STAGE(PG8_SA(0, 0), cA, voffA); PG8_STAGE(PG8_SA(0, 1), cA + hstepA, voffA);
    if (wr == 1) PG8_BAR;
    PG8_WAIT_V(2); PG8_BAR;
    PG8_STAGE(PG8_SB(1, 0), cB + kstep, voffB); PG8_STAGE(PG8_SA(1, 0), cA + kstep, voffA); PG8_STAGE(PG8_SB(1, 1), cB + hstepB + kstep, voffB);
    PG8_WAIT_V(6); PG8_BAR;
    for (;;) {
        const bool has_next = S.next(ui + 1, nxt);
        const char* nA = has_next ? nxt.A : cA; const char* nB = has_next ? nxt.B : cB;
        for (int t = 0; t < nt; t += 2) {
            const bool last = (t == nt - 2);
            const char* a1 = cA + (size_t)(t + 1) * kstep;
            const char* a2 = last ? nA : cA + (size_t)(t + 2) * kstep; const char* b2 = last ? nB : cB + (size_t)(t + 2) * kstep;
            const char* a3 = a2 + kstep; const char* b3 = b2 + kstep;
            PG8_LDB(B0, 0, 0); PG8_LDB(B1, 0, 1); PG8_SCHED; PG8_LDA(At, 0, 0); PG8_STAGE(PG8_SA(1, 1), a1 + hstepA, voffA);
            PG8_WAIT_V(8); PG8_WAIT_L(0); PG8_BAR; PG8_MMA(0, 0, At, B0); PG8_MMA(0, 1, At, B1); PG8_BAR; PG8_SCHED;
            PG8_LDA(At, 0, 1); PG8_STAGE(PG8_SB(0, 0), b2, voffB); PG8_STAGE(PG8_SB(0, 1), b2 + hstepB, voffB); PG8_STAGE(PG8_SA(0, 0), a2, voffA);
            PG8_WAIT_V(8); PG8_WAIT_L(0); PG8_BAR; PG8_MMA(1, 0, At, B0); PG8_MMA(1, 1, At, B1); PG8_BAR; PG8_SCHED;
            PG8_LDB(B0, 1, 0); PG8_LDB(B1, 1, 1); PG8_SCHED; PG8_LDA(At, 1, 0); PG8_STAGE(PG8_SA(0, 1), a2 + hstepA, voffA);
            PG8_WAIT_V(8); PG8_WAIT_L(0); PG8_BAR; PG8_MMA(0, 0, At, B0); PG8_MMA(0, 1, At, B1); PG8_BAR; PG8_SCHED;
            PG8_LDA(At, 1, 1); PG8_STAGE(PG8_SB(1, 0), b3, voffB); PG8_STAGE(PG8_SB(1, 1), b3 + hstepB, voffB); PG8_STAGE(PG8_SA(1, 0), a3, voffA);
            PG8_WAIT_V(8); PG8_WAIT_L(0); PG8_BAR; PG8_MMA(1, 0, At, B0); PG8_MMA(1, 1, At, B1); PG8_BAR; PG8_SCHED;
        }
        if (wr == 0) PG8_BAR;
        const bool keep = E(acc, cur, wr, wc, fr, fq);
        if (!has_next) break;
        if (!keep) PG8_ZERO();
        cur = nxt; cA = nA; cB = nB; ++ui;
        if (wr == 1) PG8_BAR;
    }
    PG8_WAIT_V(0);
    PG8_BAR;
#undef PG8_SA
#undef PG8_SB
#undef PG8_STAGE
#undef PG8_LDA
#undef PG8_LDB
#undef PG8_MMA
#undef PG8_WAIT_V
#undef PG8_WAIT_L
#undef PG8_BAR
#undef PG8_SCHED
#undef PG8_ZERO
}
}

typedef __attribute__((address_space(1))) unsigned gu32;
#define XB_TMO      128
#define XB_XCNT(j)  (256  + 64 * (j))
#define XB_XSUB(j)  (1280 + 64 * (j))
#define XB_XGEN(j)  (2304 + 64 * (j))
#define XB_TOP      3328
#define XB_TOPGEN   3392
#define XCD_BAR_WORDS 3456
#define XB_SPIN_CAP (1u << 18)
__device__ __forceinline__ unsigned xb_ld(unsigned* p)              { return __hip_atomic_load(p, __ATOMIC_RELAXED, __HIP_MEMORY_SCOPE_AGENT); }
__device__ __forceinline__ unsigned xb_add(unsigned* p, unsigned v) { return __hip_atomic_fetch_add(p, v, __ATOMIC_RELAXED, __HIP_MEMORY_SCOPE_AGENT); }
__device__ __forceinline__ unsigned xb_xcc_id() { return (unsigned)__builtin_amdgcn_s_getreg((3 << 11) | 20) & 0xFu; }
#define XB_SPIN(cond, bar) do { unsigned _sp = 0; while (cond) { __builtin_amdgcn_s_sleep(1); \
    if ((++_sp & 255u) == 0u) { if (xb_ld(&(bar)[XB_TMO])) break; if (_sp > XB_SPIN_CAP) { atomicAdd(&(bar)[XB_TMO], 1u); break; } } } } while (0)
struct XcdBarrier { unsigned* bar; unsigned x; volatile LAS unsigned* st; };
__device__ __forceinline__ XcdBarrier xcd_barrier_post(unsigned* bar, volatile LAS unsigned* st) {
    XcdBarrier b; b.bar = bar; b.x = xb_xcc_id(); b.st = st;
    if (threadIdx.x == 0) (void)xb_add(&bar[XB_XCNT(b.x)], 1u);
    return b;
}
__device__ __forceinline__ void xcd_barrier_complete(unsigned* bar, unsigned x, unsigned& nloc, unsigned& nx) {
    const unsigned G = gridDim.x * gridDim.y * gridDim.z;
    unsigned sum, cnt, mine, sp = 0u;
    for (;;) {
        sum = 0u; cnt = 0u; mine = 0u;
#pragma unroll
        for (unsigned j = 0; j < 16; ++j) { const unsigned c = xb_ld(&bar[XB_XCNT(j)]); sum += c; cnt += (c > 0u) ? 1u : 0u; mine = (j == x) ? c : mine; }
        if (sum == G) break;
        __builtin_amdgcn_s_sleep(1);
        if ((++sp & 255u) == 0u) { if (xb_ld(&bar[XB_TMO])) break; if (sp > XB_SPIN_CAP) { atomicAdd(&bar[XB_TMO], 1u); break; } }
    }
    nloc = mine > 0u ? mine : 1u; nx = cnt > 0u ? cnt : 1u;
}
__device__ __forceinline__ void xcd_barrier(const XcdBarrier& b) {
    asm volatile("s_waitcnt vmcnt(0)" ::: "memory");
    __syncthreads();
    if (threadIdx.x == 0) {
        unsigned* bar = b.bar;
        __builtin_amdgcn_s_waitcnt(0);
        unsigned nloc = b.st[0], nx = b.st[1];
        if (nloc == 0u) { xcd_barrier_complete(bar, b.x, nloc, nx); b.st[0] = nloc; b.st[1] = nx; }
        const unsigned old = xb_add(&bar[XB_XSUB(b.x)], 1u);
        const unsigned gen = old / nloc;
        if (old + 1u == (gen + 1u) * nloc) {
            __builtin_amdgcn_fence(__ATOMIC_RELEASE, "agent");
            asm volatile("s_waitcnt vmcnt(0)" ::: "memory");
            const unsigned og = xb_add(&bar[XB_TOP], 1u);
            const unsigned tg = og / nx;
            if (og + 1u == (tg + 1u) * nx) xb_add(&bar[XB_TOPGEN], 1u);
            else XB_SPIN(xb_ld(&bar[XB_TOPGEN]) == tg, bar);
            __builtin_amdgcn_fence(__ATOMIC_ACQUIRE, "agent");
            xb_add(&bar[XB_XGEN(b.x)], 1u);
            asm volatile("s_waitcnt vmcnt(0)" ::: "memory");
        } else {
            XB_SPIN(xb_ld(&bar[XB_XGEN(b.x)]) == gen, bar);
            __builtin_amdgcn_fence(__ATOMIC_ACQUIRE, "agent");
            asm volatile("s_waitcnt vmcnt(0)" ::: "memory");
        }
    }
    __syncthreads();
}
__device__ __forceinline__ void rmsnorm_rows_h16(const float* __restrict__ src, const float* __restrict__ g, h16* dst) {
    int tid_ = threadIdx.x; asm volatile("" : "+v"(tid_));
    const int lane = tid_ & 63, wv = tid_ >> 6, nwv = blockDim.x >> 6;
    f32x4 gg[4];
#pragma unroll
    for (int j = 0; j < 4; ++j) gg[j] = ((const f32x4*)g)[lane + 64 * j];
    for (int r = 2 * (blockIdx.x * nwv + wv); r < M; r += 2 * gridDim.x * nwv) {
        f32x4 v[2][4]; float s[2] = {0.f, 0.f};
#pragma unroll
        for (int q = 0; q < 2; ++q)
#pragma unroll
            for (int j = 0; j < 4; ++j) v[q][j] = __builtin_nontemporal_load((const f32x4*)(src + (size_t)(r + q) * DM) + lane + 64 * j);
#pragma unroll
        for (int q = 0; q < 2; ++q) {
#pragma unroll
            for (int j = 0; j < 4; ++j) s[q] += (v[q][j][0] * v[q][j][0] + v[q][j][1] * v[q][j][1]) + (v[q][j][2] * v[q][j][2] + v[q][j][3] * v[q][j][3]);
            const float rs = rsqrtf(wave_sum(s[q]) * (1.f / DM) + EPS);
#pragma unroll
            for (int j = 0; j < 4; ++j) { const f32x4 o = v[q][j] * rs * gg[j]; uint2 w; w.x = pk2h(o[0], o[1]); w.y = pk2h(o[2], o[3]); *(uint2*)(dst + (size_t)(r + q) * DM + (lane + 64 * j) * 4) = w; }
        }
    }
}

__device__ __forceinline__ unsigned wave_suffix_sum(unsigned v, int lane) {
#pragma unroll
    for (int o = 1; o < 64; o <<= 1) { const unsigned t = __shfl_down(v, o); if (lane + o < 64) v += t; }
    return v;
}

__device__ __forceinline__ unsigned okey2(unsigned x) { const unsigned m = ((x >> 15) & 0x00010001u) * 0xFFFFu; return x ^ (m | 0x80008000u); }
__device__ __forceinline__ unsigned wave_incl_scan(unsigned v, int lane) {
    (void)lane;
    int x = (int)v;
    x += __builtin_amdgcn_update_dpp(0, x, 0x111, 0xf, 0xf, false);
    x += __builtin_amdgcn_update_dpp(0, x, 0x112, 0xf, 0xf, false);
    x += __builtin_amdgcn_update_dpp(0, x, 0x114, 0xf, 0xf, false);
    x += __builtin_amdgcn_update_dpp(0, x, 0x118, 0xf, 0xf, false);
    x += __builtin_amdgcn_update_dpp(0, x, 0x142, 0xa, 0xf, false);
    x += __builtin_amdgcn_update_dpp(0, x, 0x143, 0xc, 0xf, false);
    return (unsigned)x;
}
__device__ __forceinline__ void hist_find4(const LAS unsigned* hist, int lane, unsigned k, unsigned& bucket, unsigned& need, unsigned& bcnt) {
    u32x4 h = *(const LAS u32x4*)(hist + 4 * lane);
#pragma unroll
    for (int c = 1; c < 4; ++c) h += *(const LAS u32x4*)(hist + c * 256 + 4 * lane);
    const unsigned s = h[0] + h[1] + h[2] + h[3];
    const unsigned pin = wave_incl_scan(s, lane);
    const unsigned S = (unsigned)__builtin_amdgcn_readlane((int)pin, 63) - pin + s;
    const unsigned above = S - s;
    const bool mine = (above < k) && (S >= k);
    unsigned bk = 0, nd = 0, bc = 0;
    if (mine) {
        unsigned cum = above;
        if (cum + h[3] >= k) { bk = 4 * lane + 3; nd = k - cum; bc = h[3]; }
        else { cum += h[3]; if (cum + h[2] >= k) { bk = 4 * lane + 2; nd = k - cum; bc = h[2]; }
        else { cum += h[2]; if (cum + h[1] >= k) { bk = 4 * lane + 1; nd = k - cum; bc = h[1]; }
        else { cum += h[1]; bk = 4 * lane; nd = k - cum; bc = h[0]; } } }
    }
    const unsigned long long mk = __ballot(mine);
    const int src = mk ? (int)__builtin_ctzll(mk) : 0;
    bucket = __shfl(bk, src); need = __shfl(nd, src); bcnt = __shfl(bc, src);
}
__device__ __forceinline__ void select_phase2(const h16* __restrict__ SC, unsigned short* IDX, LAS unsigned char* lds) {
    int tid_ = threadIdx.x; asm volatile("" : "+v"(tid_));
    const int lane = tid_ & 63, wv = __builtin_amdgcn_readfirstlane(tid_ >> 6);
    constexpr unsigned SEL_CAP = 1024;
    LAS unsigned* hist = (LAS unsigned*)(lds + wv * 8192);
    LAS unsigned* cand = hist + 1024;
    LAS unsigned* hc = hist + (lane & 3) * 256;
    const int gw = blockIdx.x * 8 + wv, ngw = gridDim.x * 8;
    auto loadrow = [&](int row, u32x4 (&v)[8]) __attribute__((always_inline)) {
        const int b = row >> 13, pos = row & (SEQ - 1), c = pos >> 6, q = pos & 63, n = (c + 1) * CH;
        if (n <= TOPK) return;
        const u32x4* sp4 = (const u32x4*)(SC + ((size_t)b * SC_BATCH + (size_t)4096 * ((size_t)c * (c + 1) / 2)) + (size_t)q * n);
#pragma unroll
        for (int j = 0; j < 8; ++j) { if (j * 512 + lane * 8 < n) v[j] = __builtin_nontemporal_load(sp4 + j * 64 + lane); else v[j] = (u32x4){0xFFFFFFFFu, 0xFFFFFFFFu, 0xFFFFFFFFu, 0xFFFFFFFFu}; }
    };
    auto process = [&](int row, u32x4 (&vp)[8]) __attribute__((always_inline)) {
        const int b = row >> 13, pos = row & (SEQ - 1), c = pos >> 6, q = pos & 63, n = (c + 1) * CH;
        unsigned short* out = IDX + (size_t)row * TOPK;
        if (n <= TOPK) { for (int j = lane; j < TOPK; j += 64) out[j] = j < n ? (unsigned short)j : (unsigned short)0xFFFF; return; }
        const u32x4* sp4 = (const u32x4*)(SC + ((size_t)b * SC_BATCH + (size_t)4096 * ((size_t)c * (c + 1) / 2)) + (size_t)q * n);
        u32x4 v[16];
#pragma unroll
        for (int j = 8; j < 16; ++j) { if (j * 512 + lane * 8 < n) v[j] = __builtin_nontemporal_load(sp4 + j * 64 + lane); else v[j] = (u32x4){0xFFFFFFFFu, 0xFFFFFFFFu, 0xFFFFFFFFu, 0xFFFFFFFFu}; }
#pragma unroll
        for (int j = 0; j < 8; ++j) v[j] = vp[j];
#pragma unroll
        for (int j = 0; j < 16; ++j) { v[j].x = okey2(v[j].x); v[j].y = okey2(v[j].y); v[j].z = okey2(v[j].z); v[j].w = okey2(v[j].w); }
#pragma unroll
        for (int i = 0; i < 4; ++i) *(LAS u32x4*)(hist + i * 256 + 4 * lane) = (u32x4){0u, 0u, 0u, 0u};
        asm volatile("s_waitcnt lgkmcnt(0)" ::: "memory");
#pragma unroll
        for (int j = 0; j < 16; ++j) if (j * 512 < n) { if (j * 512 + lane * 8 < n) {
#pragma unroll
            for (int e = 0; e < 4; ++e) { const unsigned kw = v[j][e];
                __hip_atomic_fetch_add(hc + ((kw >> 8) & 255u), 1u, __ATOMIC_RELAXED, __HIP_MEMORY_SCOPE_WORKGROUP); __hip_atomic_fetch_add(hc + (kw >> 24), 1u, __ATOMIC_RELAXED, __HIP_MEMORY_SCOPE_WORKGROUP); } } }
        asm volatile("s_waitcnt lgkmcnt(0)" ::: "memory");
        unsigned b1, k1, c1; hist_find4(hist, lane, TOPK, b1, k1, c1);
        asm volatile("s_waitcnt lgkmcnt(0)" ::: "memory");
        if (c1 <= SEL_CAP) {
            unsigned md[4] = {0u, 0u, 0u, 0u}, mc[4] = {0u, 0u, 0u, 0u};
#pragma unroll
            for (int j = 0; j < 16; ++j) if (j * 512 < n) {
                unsigned d8 = 0, c8 = 0;
#pragma unroll
                for (int e = 0; e < 4; ++e) { const unsigned kw = v[j][e], hlo = (kw >> 8) & 255u, hhi = kw >> 24;
                    d8 |= (hlo > b1 ? 1u : 0u) << (2 * e); d8 |= (hhi > b1 ? 1u : 0u) << (2 * e + 1);
                    c8 |= (hlo == b1 ? 1u : 0u) << (2 * e); c8 |= (hhi == b1 ? 1u : 0u) << (2 * e + 1); }
                md[j >> 2] |= d8 << (8 * (j & 3)); mc[j >> 2] |= c8 << (8 * (j & 3));
            }
            const unsigned nd = (unsigned)(__popc(md[0]) + __popc(md[1]) + __popc(md[2]) + __popc(md[3]));
            const unsigned nc = (unsigned)(__popc(mc[0]) + __popc(mc[1]) + __popc(mc[2]) + __popc(mc[3]));
            unsigned based = wave_incl_scan(nd, lane) - nd, basec = wave_incl_scan(nc, lane) - nc;
#pragma unroll
            for (int w = 0; w < 4; ++w) {
                unsigned m = md[w];
                while (m) { const unsigned bt = (unsigned)__builtin_ctz(m); m &= m - 1u; const unsigned idx = (unsigned)((4 * w + (bt >> 3)) * 512 + lane * 8 + (bt & 7u)); if (based < TOPK) out[based] = (unsigned short)idx; ++based; }
                m = mc[w];
                while (m) { const unsigned bt = (unsigned)__builtin_ctz(m); m &= m - 1u; const unsigned idx = (unsigned)((4 * w + (bt >> 3)) * 512 + lane * 8 + (bt & 7u)); if (basec < SEL_CAP) cand[basec] = idx; ++basec; }
            }
            asm volatile("s_waitcnt lgkmcnt(0)" ::: "memory");
            for (unsigned i = lane; i < c1; i += 64) { const unsigned idx = cand[i]; const unsigned kk = okey2((unsigned)((const unsigned short*)sp4)[idx]) & 0xFFFFu; cand[i] = ((kk & 255u) << 16) | idx; }
            asm volatile("s_waitcnt vmcnt(0) lgkmcnt(0)" ::: "memory");
#pragma unroll
            for (int i = 0; i < 4; ++i) *(LAS u32x4*)(hist + i * 256 + 4 * lane) = (u32x4){0u, 0u, 0u, 0u};
            asm volatile("s_waitcnt lgkmcnt(0)" ::: "memory");
            for (unsigned i = lane; i < c1; i += 64) __hip_atomic_fetch_add(hist + (cand[i] >> 16), 1u, __ATOMIC_RELAXED, __HIP_MEMORY_SCOPE_WORKGROUP);
            asm volatile("s_waitcnt lgkmcnt(0)" ::: "memory");
            unsigned b2, k2, tt; hist_find4(hist, lane, k1, b2, k2, tt);
            asm volatile("s_waitcnt lgkmcnt(0)" ::: "memory");
            unsigned ob = TOPK - k1, tcount = 0;
            LAS unsigned* tl = hist;
            for (unsigned i0 = 0; i0 < c1; i0 += 64) {
                const unsigned i = i0 + lane; const bool inr = i < c1;
                const unsigned cv = inr ? cand[i] : 0u, lo = cv >> 16, idx = cv & 0xFFFFu;
                const bool take = inr && lo > b2, tie = inr && lo == b2;
                const unsigned long long mt = __ballot(take), mq = __ballot(tie), ltm = (1ull << lane) - 1ull;
                const unsigned ps = ob + (unsigned)__popcll(mt & ltm);
                if (take && ps < TOPK) out[ps] = (unsigned short)idx;
                if (tie) tl[tcount + (unsigned)__popcll(mq & ltm)] = idx;
                ob += (unsigned)__popcll(mt); tcount += (unsigned)__popcll(mq);
            }
            asm volatile("s_waitcnt lgkmcnt(0)" ::: "memory");
            if (tt == k2) { for (unsigned i = lane; i < tt; i += 64) { const unsigned ps = ob + i; if (ps < TOPK) out[ps] = (unsigned short)tl[i]; } }
            else {
                for (unsigned i0 = 0; i0 < tt; i0 += 64) {
                    const unsigned i = i0 + lane; const bool inr = i < tt; const unsigned my = inr ? tl[i] : 0xFFFFFFFFu;
                    unsigned rk = 0; for (unsigned q2 = 0; q2 < tt; ++q2) rk += tl[q2] < my ? 1u : 0u;
                    if (inr && rk < k2 && ob + rk < TOPK) out[ob + rk] = (unsigned short)my;
                }
            }
            asm volatile("s_waitcnt lgkmcnt(0)" ::: "memory");
        } else {
#pragma unroll
        for (int i = 0; i < 4; ++i) *(LAS u32x4*)(hist + i * 256 + 4 * lane) = (u32x4){0u, 0u, 0u, 0u};
        asm volatile("s_waitcnt lgkmcnt(0)" ::: "memory");
#pragma unroll
        for (int j = 0; j < 16; ++j) if (j * 512 < n) {
#pragma unroll
            for (int e = 0; e < 4; ++e) { const unsigned kw = v[j][e];
                if (((kw >> 8) & 255u) == b1) __hip_atomic_fetch_add(hc + (kw & 255u), 1u, __ATOMIC_RELAXED, __HIP_MEMORY_SCOPE_WORKGROUP);
                if ((kw >> 24) == b1) __hip_atomic_fetch_add(hc + ((kw >> 16) & 255u), 1u, __ATOMIC_RELAXED, __HIP_MEMORY_SCOPE_WORKGROUP); } }
        asm volatile("s_waitcnt lgkmcnt(0)" ::: "memory");
        unsigned b2, k2, tt; hist_find4(hist, lane, k1, b2, k2, tt);
        asm volatile("s_waitcnt lgkmcnt(0)" ::: "memory");
        const unsigned T = (b1 << 8) | b2;
        const bool all_ties = (tt == k2);
        if (all_ties) {
            unsigned msk[4] = {0u, 0u, 0u, 0u};
#pragma unroll
            for (int j = 0; j < 16; ++j) if (j * 512 < n) {
                unsigned tk = 0;
#pragma unroll
                for (int e = 0; e < 4; ++e) { const unsigned kw = v[j][e]; tk |= ((kw & 0xFFFFu) >= T ? 1u : 0u) << (2 * e); tk |= ((kw >> 16) >= T ? 1u : 0u) << (2 * e + 1); }
                msk[j >> 2] |= tk << (8 * (j & 3));
            }
            const unsigned cn = (unsigned)(__popc(msk[0]) + __popc(msk[1]) + __popc(msk[2]) + __popc(msk[3]));
            unsigned base = wave_incl_scan(cn, lane) - cn;
#pragma unroll
            for (int j = 0; j < 16; ++j) if (j * 512 < n) {
                const unsigned tk = (msk[j >> 2] >> (8 * (j & 3))) & 255u;
                if (__ballot(tk != 0u)) {
#pragma unroll
                    for (int e = 0; e < 8; ++e) if ((tk >> e) & 1u) { if (base < TOPK) out[base] = (unsigned short)(j * 512 + lane * 8 + e); ++base; }
                }
            }
        } else {
        unsigned run = 0, trun = 0;
#pragma unroll
        for (int j = 0; j < 16; ++j) if (j * 512 < n) {
            unsigned tk = 0, tm = 0;
#pragma unroll
            for (int e = 0; e < 4; ++e) { const unsigned kw = v[j][e], klo = kw & 0xFFFFu, khi = kw >> 16;
                tk |= (klo > T ? 1u : 0u) << (2 * e); tk |= (khi > T ? 1u : 0u) << (2 * e + 1);
                tm |= (klo == T ? 1u : 0u) << (2 * e); tm |= (khi == T ? 1u : 0u) << (2 * e + 1); }
            {
                const unsigned tc = (unsigned)__popc(tm);
                const unsigned tin = wave_incl_scan(tc, lane);
                const unsigned tbase = trun + tin - tc;
#pragma unroll
                for (int e = 0; e < 8; ++e) if (((tm >> e) & 1u) && (tbase + (unsigned)__popc(tm & ((1u << e) - 1u))) < k2) tk |= 1u << e;
                trun += (unsigned)__shfl(tin, 63);
            }
            const unsigned cn = (unsigned)__popc(tk);
            const unsigned inc = wave_incl_scan(cn, lane);
            unsigned base = run + inc - cn;
#pragma unroll
            for (int e = 0; e < 8; ++e) if ((tk >> e) & 1u) { if (base < TOPK) out[base] = (unsigned short)(j * 512 + lane * 8 + e); ++base; }
            run += (unsigned)__shfl(inc, 63);
        }
        }
        }
    };
    auto rowof = [&](int i) __attribute__((always_inline)) -> int {
        if (ngw != 2048) { const long r = (long)gw + (long)i * ngw; return r < M ? (int)r : -1; }
        if (i >= 8) return -1;
        const int j = i & 3, pos = j == 0 ? gw : (j == 1 ? 4095 - gw : (j == 2 ? 4096 + gw : 8191 - gw));
        return (i >> 2) * SEQ + pos;
    };
    u32x4 vA[8], vB[8];
    int it = 0, row = rowof(0);
    if (row >= 0) loadrow(row, vA);
    while (row >= 0) {
        const int r1 = rowof(it + 1), r2 = rowof(it + 2);
        if (r1 >= 0) loadrow(r1, vB);
        process(row, vA);
        if (r2 >= 0) loadrow(r2, vA);
        if (r1 >= 0) process(r1, vB);
        row = r2; it += 2;
    }
}

typedef float f32x16 __attribute__((ext_vector_type(16)));
__device__ __forceinline__ void scores_phase(const h16* __restrict__ QI, const h16* __restrict__ KI, const float* __restrict__ WI, h16* SC, LAS unsigned char* lds) {
    int tid_ = threadIdx.x; asm volatile("" : "+v"(tid_));
    const int tid = tid_, lane = tid & 63, wv = __builtin_amdgcn_readfirstlane(tid >> 6), r32 = lane & 31, hi = lane >> 5;
    for (int bx = blockIdx.x; bx < 256; bx += gridDim.x) {
    const int b = bx >> 7, jj = (bx >> 1) & 63, par = bx & 1;
    const int rho_s = tid >> 3, cp_s = tid & 7;
    const int skey = 2 * (rho_s & 31) + (rho_s >> 5), schunk = cp_s ^ ((rho_s >> 1) & 7);
    const h16* ksrc0 = KI + ((size_t)b * SEQ + skey) * IDIM + schunk * 8;
    for (int uu = 0; uu < 2; ++uu) {
        const int c = uu == 0 ? jj : (NCH - 1 - jj);
        const int n = (c + 1) * CH;
        const int nmy = (c + 1 - par + 1) >> 1;
        const size_t row0 = (size_t)b * SEQ + (size_t)c * CH + wv * 8;
        h16x8 A[4][4]; h16x8 w[4][2];
#pragma unroll
        for (int pr = 0; pr < 4; ++pr) {
            const h16* ap = QI + (row0 + 2 * pr + ((r32 >> 2) & 1)) * DM + ((r32 & 3) + 4 * (r32 >> 3)) * IDIM + 8 * hi;
#pragma unroll
            for (int ks = 0; ks < 4; ++ks) A[pr][ks] = *(const h16x8*)(ap + 16 * ks);
            const float* wp = WI + (row0 + 2 * pr + hi) * IH;
#pragma unroll
            for (int i = 0; i < 2; ++i) { const f32x4 t4 = *(const f32x4*)(wp + 8 * i), t5 = *(const f32x4*)(wp + 8 * i + 4); w[pr][i] = __builtin_bit_cast(h16x8, pack8(t4, t5)); }
        }
        h16* scq = SC + ((size_t)b * SC_BATCH + (size_t)4096 * ((size_t)c * (c + 1) / 2)) + (size_t)(wv * 8 + hi) * n + 2 * r32;
        asm volatile("s_waitcnt vmcnt(0)" ::: "memory");
#pragma unroll
        for (int pr = 0; pr < 4; ++pr) asm volatile("" : "+v"(A[pr][0]), "+v"(A[pr][1]), "+v"(A[pr][2]), "+v"(A[pr][3]), "+v"(w[pr][0]), "+v"(w[pr][1]));
        __syncthreads();
        if (nmy > 0) __builtin_amdgcn_global_load_lds((const unsigned*)(ksrc0 + (size_t)par * CH * IDIM), (LAS unsigned*)(lds + wv * 1024), 16, 0, 0);
        if (nmy > 1) __builtin_amdgcn_global_load_lds((const unsigned*)(ksrc0 + (size_t)(par + 2) * CH * IDIM), (LAS unsigned*)(lds + 8192 + wv * 1024), 16, 0, 0);
        for (int i = 0; i < nmy; ++i) {
            const int t = par + 2 * i;
            if (i == 0) { if (nmy > 1) asm volatile("s_waitcnt vmcnt(1)" ::: "memory"); else asm volatile("s_waitcnt vmcnt(0)" ::: "memory"); }
            else if (i == 1) { if (i + 1 < nmy) asm volatile("s_waitcnt vmcnt(5)" ::: "memory"); else asm volatile("s_waitcnt vmcnt(4)" ::: "memory"); }
            else if (i + 1 < nmy) asm volatile("s_waitcnt vmcnt(9)" ::: "memory"); else asm volatile("s_waitcnt vmcnt(8)" ::: "memory");
            __builtin_amdgcn_s_barrier();
            if (i + 2 < nmy) __builtin_amdgcn_global_load_lds((const unsigned*)(ksrc0 + (size_t)(t + 4) * CH * IDIM), (LAS unsigned*)(lds + ((i + 2) % 3) * 8192 + wv * 1024), 16, 0, 0);
            const LAS unsigned char* buf = lds + (i % 3) * 8192;
            float sc[2][4];
#pragma unroll
            for (int f = 0; f < 2; ++f) {
                const int rho = f * 32 + r32;
                h16x8 B[4];
#pragma unroll
                for (int ks = 0; ks < 4; ++ks) B[ks] = *(const LAS h16x8*)(buf + rho * 128 + (((ks * 2 + hi) ^ ((rho >> 1) & 7)) << 4));
#pragma unroll
                for (int pr = 0; pr < 4; ++pr) {
                    f32x16 acc;
#pragma unroll
                    for (int e = 0; e < 16; ++e) acc[e] = 0.f;
                    __builtin_amdgcn_s_setprio(1);
#pragma unroll
                    for (int ks = 0; ks < 4; ++ks) acc = __builtin_amdgcn_mfma_f32_32x32x16_f16(A[pr][ks], B[ks], acc, 0, 0, 0);
                    __builtin_amdgcn_s_setprio(0);
                    float s = 0.f;
#pragma unroll
                    for (int e = 0; e < 16; ++e) { const float xe = acc[e]; int ib = __float_as_int(xe); ib = ib > 0 ? ib : 0;
                        s = __builtin_fmaf(__int_as_float(ib), (float)w[pr][e >> 3][e & 7], s); }
                    sc[f][pr] = s;
                }
            }
#pragma unroll
            for (int pr = 0; pr < 4; ++pr) __builtin_nontemporal_store(pk2h(sc[0][pr], sc[1][pr]), (unsigned*)(scq + (size_t)(2 * pr) * n + t * CH));
        }
    }
    }
    asm volatile("s_waitcnt vmcnt(0)" ::: "memory");
    __syncthreads();
}

typedef _Float16 h16x4 __attribute__((ext_vector_type(4)));
__device__ __forceinline__ void tr8(h16x4 (&r)[8], unsigned a0, unsigned a1, unsigned a2, unsigned a3, unsigned a4, unsigned a5, unsigned a6, unsigned a7) {
    asm volatile("ds_read_b64_tr_b16 %0, %8\n\tds_read_b64_tr_b16 %1, %9\n\tds_read_b64_tr_b16 %2, %10\n\tds_read_b64_tr_b16 %3, %11\n\t"
                 "ds_read_b64_tr_b16 %4, %12\n\tds_read_b64_tr_b16 %5, %13\n\tds_read_b64_tr_b16 %6, %14\n\tds_read_b64_tr_b16 %7, %15\n\ts_waitcnt lgkmcnt(0)"
                 : "=&v"(r[0]), "=&v"(r[1]), "=&v"(r[2]), "=&v"(r[3]), "=&v"(r[4]), "=&v"(r[5]), "=&v"(r[6]), "=&v"(r[7])
                 : "v"(a0), "v"(a1), "v"(a2), "v"(a3), "v"(a4), "v"(a5), "v"(a6), "v"(a7) : "memory");
}
__device__ __forceinline__ void tr8b(long (&r)[8], unsigned a0, unsigned a1, unsigned a2, unsigned a3, unsigned a4, unsigned a5, unsigned a6, unsigned a7) {
    asm volatile("ds_read_b64_tr_b8 %0, %8\n\tds_read_b64_tr_b8 %1, %9\n\tds_read_b64_tr_b8 %2, %10\n\tds_read_b64_tr_b8 %3, %11\n\t"
                 "ds_read_b64_tr_b8 %4, %12\n\tds_read_b64_tr_b8 %5, %13\n\tds_read_b64_tr_b8 %6, %14\n\tds_read_b64_tr_b8 %7, %15\n\ts_waitcnt lgkmcnt(0)"
                 : "=&v"(r[0]), "=&v"(r[1]), "=&v"(r[2]), "=&v"(r[3]), "=&v"(r[4]), "=&v"(r[5]), "=&v"(r[6]), "=&v"(r[7])
                 : "v"(a0), "v"(a1), "v"(a2), "v"(a3), "v"(a4), "v"(a5), "v"(a6), "v"(a7) : "memory");
}
__device__ __forceinline__ void attn_phase(const h16* __restrict__ Q, const h16* __restrict__ K, const h16* __restrict__ V, const unsigned short* __restrict__ IDX, h16* YB, LAS unsigned char* lds) {
    int tid_ = threadIdx.x; asm volatile("" : "+v"(tid_));
    const int lane = tid_ & 63, wv = __builtin_amdgcn_readfirstlane(tid_ >> 6), c16 = lane & 15, gg = lane >> 4;
    LAS unsigned char* wl = lds + wv * 17408;
    LAS unsigned short* ktab = (LAS unsigned short*)(wl + 16384);
    LAS unsigned short* vtab = ktab + 256;
    const int tabK = (((lane >> 3) * 8 + 4 * (lane & 1)) * 4 + ((lane >> 1) & 3)), tabV = (((lane >> 3) * 8 + 4 * ((lane >> 2) & 1)) * 4 + (lane & 3));
    const unsigned trbase8 = (unsigned)(size_t)wl + (unsigned)((8 * gg + (c16 >> 1)) * 128 + 8 * (c16 & 1));
    const unsigned trx8 = (unsigned)(((4 * (gg & 1) + (c16 >> 2)) & 7) << 4);
    const int bx = blockIdx.x, xl = bx & 7, ci = bx >> 3;
    const int gfix = (xl >> 1) & 1;
    const unsigned loffA = (unsigned)(gfix * 128 + 16 * ((lane & 7) ^ (lane >> 4))), loffB = (unsigned)(gfix * 128 + 16 * ((lane & 7) ^ (4 + (lane >> 4))));
    const float SCL = 0.08838834764831845f * 1.4426950408889634f;
    const int rowbase = (xl >> 2) * SEQ + (xl & 1) * 4096 + ci * 128 + wv * 16;
    unsigned long long idr = 0ull; h16x8 qr[4];
    if (ci < 32) { idr = *(const unsigned long long*)(IDX + (size_t)rowbase * TOPK + lane * 4);
        const h16* qp = Q + (size_t)rowbase * DM + (4 * gfix + (lane & 3)) * HD + 8 * gg;
#pragma unroll
        for (int ks = 0; ks < 4; ++ks) qr[ks] = *(const h16x8*)(qp + 32 * ks); }
    const unsigned char* K8b = (const unsigned char*)K + (size_t)(rowbase >> 13) * SEQ * 256; const unsigned char* V8b = (const unsigned char*)V + (size_t)(rowbase >> 13) * SEQ * 256;
#define ATT_TAB(cc_) (*(const LAS unsigned long long*)(((cc_) < 8 ? ktab : vtab) + ((((cc_) & 7) * 8 + (lane >> 3)) * 4)))
#define ATT_DMA(cc_, w4_) do { const unsigned char* base_ = (cc_) < 8 ? K8b : V8b; _Pragma("unroll") for (int i_ = 0; i_ < 4; ++i_) { \
                const unsigned vo_ = (((unsigned)((w4_) >> (16 * i_)) & 0xFFFFu) << 8) + ((i_ & 1) ? loffB : loffA); \
                __builtin_amdgcn_global_load_lds((const unsigned*)(base_ + vo_), (LAS unsigned*)(wl + ((cc_) & 3) * 4096 + i_ * 1024), 16, 0, 0); } } while (0)
#define ATT_WRITE_TABLES() do { _Pragma("unroll") for (int e = 0; e < 4; ++e) { unsigned idv = (unsigned)(idr >> (16 * e)) & 0xFFFFu; idv = idv == 0xFFFFu ? 0u : idv;     \
            ktab[tabK + 4 * e] = (unsigned short)idv; vtab[tabV + 4 * e] = (unsigned short)idv; } asm volatile("" ::: "memory");     } while (0)
    unsigned long long idn = 0ull;
    if (ci < 32) { ATT_WRITE_TABLES();
        const unsigned long long w0 = ATT_TAB(0), w1 = ATT_TAB(1), w2 = ATT_TAB(2); idn = ATT_TAB(3); asm volatile("s_waitcnt lgkmcnt(0)" ::: "memory"); ATT_DMA(0, w0); ATT_DMA(1, w1); ATT_DMA(2, w2); }
    for (int qi = 0; qi < 16; ++qi) {
        const int row = rowbase + qi;
        if (ci >= 32) break;
        const int pos = row & (SEQ - 1);
        const int nadm = ((pos >> 6) + 1) * CH, nvalid = nadm < TOPK ? nadm : TOPK;
        { const int g = gfix;
            long Bq[4];
#pragma unroll
            for (int ks = 0; ks < 4; ++ks) { const h16x8 qv = qr[ks]; int lo = 0, hi2 = 0;
                lo = __builtin_amdgcn_cvt_pk_fp8_f32((float)qv[0], (float)qv[1], lo, false); lo = __builtin_amdgcn_cvt_pk_fp8_f32((float)qv[2], (float)qv[3], lo, true);
                hi2 = __builtin_amdgcn_cvt_pk_fp8_f32((float)qv[4], (float)qv[5], hi2, false); hi2 = __builtin_amdgcn_cvt_pk_fp8_f32((float)qv[6], (float)qv[7], hi2, true);
                Bq[ks] = (long)(((unsigned long long)(unsigned)hi2 << 32) | (unsigned long long)(unsigned)lo); }
            asm volatile("s_waitcnt lgkmcnt(0)" : "+v"(Bq[0]), "+v"(Bq[1]), "+v"(Bq[2]), "+v"(Bq[3]) :: "memory");
            { const int rn = qi + 1 < 16 ? row + 1 : row;
                const unsigned short* ip = IDX + (size_t)rn * TOPK + lane * 4;
                const h16* qp = Q + (size_t)rn * DM + (4 * g + (lane & 3)) * HD + 8 * gg;
                asm volatile("global_load_dwordx2 %0, %5, off\n\tglobal_load_dwordx4 %1, %6, off\n\tglobal_load_dwordx4 %2, %6, off offset:64\n\tglobal_load_dwordx4 %3, %6, off offset:128\n\tglobal_load_dwordx4 %4, %6, off offset:192"
                             : "=&v"(idr), "=&v"(qr[0]), "=&v"(qr[1]), "=&v"(qr[2]), "=&v"(qr[3]) : "v"(ip), "v"(qp) : "memory"); }
#define ATT_STEP_WAIT(c_) do { asm volatile("s_waitcnt lgkmcnt(0)" ::: "memory"); \
                if ((c_) <= 12) ATT_DMA((c_) + 3, idn); else ATT_DMA((c_) - 13, idn); \
                if ((c_) == 12) ATT_WRITE_TABLES(); \
                idn = ATT_TAB(((c_) + 4) & 15); \
                if ((c_) < 3) asm volatile("s_waitcnt vmcnt(17)" ::: "memory"); else asm volatile("s_waitcnt vmcnt(12)" ::: "memory"); } while (0)
            f32x4 S[16];
#pragma unroll
            for (int c = 0; c < 8; ++c) {
                ATT_STEP_WAIT(c);
#pragma unroll
                for (int h2 = 0; h2 < 2; ++h2) {
                    const LAS unsigned char* kb_ = wl + (c & 3) * 4096 + (16 * h2 + c16) * 128;
                    f32x4 acc = (f32x4){0.f, 0.f, 0.f, 0.f};
#pragma unroll
                    for (int ks = 0; ks < 4; ++ks) { const long a = *(const LAS long*)(kb_ + (((2 * ks + (gg >> 1)) ^ (c16 >> 1)) << 4) + (gg & 1) * 8); acc = __builtin_amdgcn_mfma_f32_16x16x32_fp8_fp8(a, Bq[ks], acc, 0, 0, 0); }
                    S[2 * c + h2] = acc;
                }
            }
            float mx = -1e30f;
#pragma unroll
            for (int t = 0; t < 16; ++t)
#pragma unroll
                for (int r = 0; r < 4; ++r) { const float s = (16 * t + 4 * gg + r) < nvalid ? S[t][r] * SCL : -1e30f; S[t][r] = s; mx = fmaxf(mx, s); }
            mx = fmaxf(mx, __shfl_xor(mx, 16)); mx = fmaxf(mx, __shfl_xor(mx, 32));
            float sum = 0.f;
#pragma unroll
            for (int t = 0; t < 16; ++t)
#pragma unroll
                for (int r = 0; r < 4; ++r) { const float pv = __builtin_amdgcn_exp2f(S[t][r] - mx); S[t][r] = pv; sum += pv; }
            sum += __shfl_xor(sum, 16); sum += __shfl_xor(sum, 32);
            long Pk[8];
#pragma unroll
            for (int s = 0; s < 8; ++s) { int lo = 0, hi2 = 0;
                lo = __builtin_amdgcn_cvt_pk_fp8_f32(S[2 * s][0] * 256.f, S[2 * s][1] * 256.f, lo, false); lo = __builtin_amdgcn_cvt_pk_fp8_f32(S[2 * s][2] * 256.f, S[2 * s][3] * 256.f, lo, true);
                hi2 = __builtin_amdgcn_cvt_pk_fp8_f32(S[2 * s + 1][0] * 256.f, S[2 * s + 1][1] * 256.f, hi2, false); hi2 = __builtin_amdgcn_cvt_pk_fp8_f32(S[2 * s + 1][2] * 256.f, S[2 * s + 1][3] * 256.f, hi2, true);
                Pk[s] = (long)(((unsigned long long)(unsigned)hi2 << 32) | (unsigned long long)(unsigned)lo); }
            f32x4 O[8];
#pragma unroll
            for (int mt = 0; mt < 8; ++mt) O[mt] = (f32x4){0.f, 0.f, 0.f, 0.f};
#pragma unroll
            for (int c = 8; c < 16; ++c) {
                ATT_STEP_WAIT(c);
                long av[8];
                { const unsigned rb = trbase8 + (c & 3) * 4096;
                  tr8b(av, rb + (trx8 ^ 0u), rb + (trx8 ^ 16u), rb + (trx8 ^ 32u), rb + (trx8 ^ 48u), rb + (trx8 ^ 64u), rb + (trx8 ^ 80u), rb + (trx8 ^ 96u), rb + (trx8 ^ 112u)); }
#pragma unroll
                for (int mt = 0; mt < 8; ++mt) O[mt] = __builtin_amdgcn_mfma_f32_16x16x32_fp8_fp8(av[mt], Pk[c - 8], O[mt], 0, 0, 0);
            }
#undef ATT_STEP_WAIT
            const float inv = __builtin_amdgcn_rcpf(sum) * (1.f / 256.f);
            if (c16 < 4) {
                h16* op = YB + (size_t)row * DM + (4 * g + c16) * HD + 4 * gg;
#pragma unroll
                for (int mt = 0; mt < 8; ++mt) { uint2 o2; o2.x = pk2h(O[mt][0] * inv, O[mt][1] * inv); o2.y = pk2h(O[mt][2] * inv, O[mt][3] * inv); *(uint2*)(op + 16 * mt) = o2; }
            }
        }
    }
    asm volatile("s_waitcnt vmcnt(0) lgkmcnt(0)" ::: "memory");
#undef ATT_TAB
#undef ATT_DMA
#undef ATT_WRITE_TABLES
}

typedef f32x4 AccT[2][2][4][2];
#define EPI_ROWS(u) const int row0 = (u).pm * 256 + wr * 64 + fr, cw0 = wc * 32 + 8 * fq
#define EPI_FOR _Pragma("unroll") for (int ai = 0; ai < 2; ++ai) _Pragma("unroll") for (int m = 0; m < 4; ++m)

struct EpiInProj {
    h16 *U, *Q, *K, *V, *QI, *KI; float* WI;
    static __device__ __forceinline__ void rot8(f32x4& a, f32x4& b, const f32x4& pa, const f32x4& pb, float fpos, const float (&ifr)[8], float sgn) {
#pragma unroll
        for (int j = 0; j < 4; ++j) {
            const float r0 = __builtin_amdgcn_fractf(fpos * ifr[j]), r1 = __builtin_amdgcn_fractf(fpos * ifr[4 + j]);
            a[j] = a[j] * __builtin_amdgcn_cosf(r0) + pa[j] * (sgn * __builtin_amdgcn_sinf(r0));
            b[j] = b[j] * __builtin_amdgcn_cosf(r1) + pb[j] * (sgn * __builtin_amdgcn_sinf(r1));
        }
    }
    __device__ __forceinline__ bool operator()(AccT& acc, const pg8::Unit& u, int wr, int wc, int fr, int fq) const {
        EPI_ROWS(u); const int pn = u.pn;
        const bool ropeA = (pn >= 4 && pn <= 8) && wc == 0;
        const bool ropeI = (pn >= 10 && pn <= 13 && (wc & 1) == 0) || (pn == 14 && wc == 0);
        float ifr[8];
#pragma unroll
        for (int e = 0; e < 8; ++e) ifr[e] = 0.15915494309189535f * __builtin_amdgcn_exp2f(-18.931568569324174f * (ropeA ? (float)(8 * (fq & 1) + e) * (1.f / 16.f) : (float)e * (1.f / 8.f)));
        const float sgnA = fq < 2 ? -1.f : 1.f, sgnI = fq == 0 ? -1.f : (fq == 1 ? 1.f : 0.f);
        if (pn < 4) {
            EPI_FOR { const int row = row0 + ai * 128 + m * 16;
#pragma unroll
                for (int bj = 0; bj < 2; ++bj) { const int col = pn * 256 + cw0 + bj * 128;
                    *(u32x4*)(U + ((size_t)(col >> 4) * 512 + (size_t)(row >> 5)) * 640 + (row & 31) * 16 + (col & 15)) = pack8(acc[ai][bj][m][0], acc[ai][bj][m][1]); } }
        } else if (pn < 14) {
            h16* base; int ld;
            if (pn < 8) { base = Q + (pn - 4) * 256; ld = DM; }
            else if (pn == 8) { base = K; ld = KVW; } else if (pn == 9) { base = V; ld = KVW; } else { base = QI + (pn - 10) * 256; ld = DM; }
            EPI_FOR { const size_t row = (size_t)(row0 + ai * 128 + m * 16); const float fpos = (float)((int)row & (SEQ - 1));
#pragma unroll
                for (int bj = 0; bj < 2; ++bj) { f32x4 a = acc[ai][bj][m][0], b = acc[ai][bj][m][1];
                    if (ropeA || ropeI) { f32x4 pa, pb; const int xm = ropeA ? 32 : 16;
#pragma unroll
                        for (int j = 0; j < 4; ++j) { pa[j] = __shfl_xor(a[j], xm); pb[j] = __shfl_xor(b[j], xm); }
                        if (ropeA || fq < 2) rot8(a, b, pa, pb, fpos, ifr, ropeA ? sgnA : sgnI); }
                    if (pn == 8 || pn == 9) { uint2 w8; int lo = 0, hi2 = 0;
                        unsigned char* K = pn == 8 ? (unsigned char*)this->K : (unsigned char*)this->V;
                        lo = __builtin_amdgcn_cvt_pk_fp8_f32(a[0], a[1], lo, false); lo = __builtin_amdgcn_cvt_pk_fp8_f32(a[2], a[3], lo, true);
                        hi2 = __builtin_amdgcn_cvt_pk_fp8_f32(b[0], b[1], hi2, false); hi2 = __builtin_amdgcn_cvt_pk_fp8_f32(b[2], b[3], hi2, true);
                        w8.x = (unsigned)lo; w8.y = (unsigned)hi2; *(uint2*)((unsigned char*)K + row * 256 + cw0 + bj * 128) = w8; }
                    else *(u32x4*)(base + row * ld + cw0 + bj * 128) = pack8(a, b); } }
        } else {
            EPI_FOR { const size_t row = (size_t)(row0 + ai * 128 + m * 16); const float fpos = (float)((int)row & (SEQ - 1));
                f32x4 a = acc[ai][0][m][0], b = acc[ai][0][m][1];
                if (ropeI) { f32x4 pa, pb;
#pragma unroll
                    for (int j = 0; j < 4; ++j) { pa[j] = __shfl_xor(a[j], 16); pb[j] = __shfl_xor(b[j], 16); }
                    if (fq < 2) rot8(a, b, pa, pb, fpos, ifr, sgnI); }
                if (cw0 < 64) *(u32x4*)(KI + row * IDIM + cw0) = pack8(a, b);
                else if (cw0 < 80) { float* wp = WI + row * IH + (cw0 - 64); *(f32x4*)wp = a * (1.f / 32.f); *(f32x4*)(wp + 4) = b * (1.f / 32.f); } }
        }
        return false;
    }
};
struct EpiGlu {
    const h16* YS; h16* YA;
    __device__ __forceinline__ bool operator()(AccT& acc, const pg8::Unit& u, int wr, int wc, int fr, int fq) const {
        EPI_ROWS(u);
        EPI_FOR { const size_t row = (size_t)(row0 + ai * 128 + m * 16);
#pragma unroll
            for (int bj = 0; bj < 2; ++bj) { const size_t o = row * DM + u.pn * 256 + cw0 + bj * 128; const h16x8 y = *(const h16x8*)(YS + o);
                f32x4 a = acc[ai][bj][m][0], b = acc[ai][bj][m][1];
#pragma unroll
                for (int j = 0; j < 4; ++j) { a[j] = (float)y[j] * sigmoidf_(a[j]); b[j] = (float)y[4 + j] * sigmoidf_(b[j]); }
                *(u32x4*)(YA + o) = pack8(a, b); }
            asm volatile("" ::: "memory"); }
        return false;
    }
};
struct EpiMerge {
    h16 *SA, *SB, *MG;
    __device__ __forceinline__ bool operator()(AccT& acc, const pg8::Unit& u, int wr, int wc, int fr, int fq) const {
        EPI_ROWS(u); const int tag = u.tag;
        EPI_FOR { const size_t row = (size_t)(row0 + ai * 128 + m * 16);
#pragma unroll
            for (int bj = 0; bj < 2; ++bj) { const size_t o = row * DM + u.pn * 256 + cw0 + bj * 128;
                f32x4 a = acc[ai][bj][m][0], b = acc[ai][bj][m][1];
                if (tag < 2) {
#pragma unroll
                    for (int j = 0; j < 4; ++j) { a[j] = sigmoidf_(a[j]); b[j] = sigmoidf_(b[j]); }
                    *(u32x4*)((tag == 0 ? SA : SB) + o) = pack8(a, b);
                } else if (tag == 2) {
                    const h16x8 sa = *(const h16x8*)(SA + o), sb = *(const h16x8*)(SB + o);
#pragma unroll
                    for (int j = 0; j < 4; ++j) { a[j] *= (float)sa[j] * __builtin_amdgcn_rcpf((float)sb[j]); b[j] *= (float)sa[4 + j] * __builtin_amdgcn_rcpf((float)sb[4 + j]); }
                    acc[ai][bj][m][0] = a; acc[ai][bj][m][1] = b;
                } else {
                    const h16x8 sb = *(const h16x8*)(SB + o);
#pragma unroll
                    for (int j = 0; j < 4; ++j) { a[j] *= (float)sb[j]; b[j] *= (float)sb[4 + j]; }
                    *(u32x4*)(MG + o) = pack8(a, b);
                } }
            asm volatile("" ::: "memory"); }
        return tag == 2;
    }
};
struct EpiWout {
    const float* x; h16* X1h; float* SSQ;
    __device__ __forceinline__ bool operator()(AccT& acc, const pg8::Unit& u, int wr, int wc, int fr, int fq) const {
        EPI_ROWS(u);
        EPI_FOR { const size_t row = (size_t)(row0 + ai * 128 + m * 16); float ss = 0.f;
#pragma unroll
            for (int bj = 0; bj < 2; ++bj) { const size_t o = row * DM + u.pn * 256 + cw0 + bj * 128;
                const f32x4 a = acc[ai][bj][m][0] + __builtin_nontemporal_load((const f32x4*)(x + o)), b = acc[ai][bj][m][1] + __builtin_nontemporal_load((const f32x4*)(x + o + 4));
                *(u32x4*)(X1h + o) = pack8(a, b);
                ss += (a[0] * a[0] + a[1] * a[1]) + (a[2] * a[2] + a[3] * a[3]) + (b[0] * b[0] + b[1] * b[1]) + (b[2] * b[2] + b[3] * b[3]); }
            ss += __shfl_xor(ss, 16); ss += __shfl_xor(ss, 32);
            if (fq == 0) SSQ[row * 16 + u.pn * 4 + wc] = ss;
            asm volatile("" ::: "memory"); }
        return false;
    }
};
struct EpiFfnIn {
    const LAS float* rtab; h16* HID;
    __device__ __forceinline__ bool operator()(AccT& acc, const pg8::Unit& u, int wr, int wc, int fr, int fq) const {
        EPI_ROWS(u);
        EPI_FOR { const size_t row = (size_t)(row0 + ai * 128 + m * 16);
            const float rstd = rtab[u.tag * 256 + wr * 64 + fr + ai * 128 + m * 16];
            f32x4 a, b;
#pragma unroll
            for (int j = 0; j < 4; ++j) { const float g0 = acc[ai][0][m][0][j] * rstd, g1 = acc[ai][0][m][1][j] * rstd;
                a[j] = g0 * sigmoidf_(g0) * (acc[ai][1][m][0][j] * rstd); b[j] = g1 * sigmoidf_(g1) * (acc[ai][1][m][1][j] * rstd); }
            *(u32x4*)(HID + row * FF + u.pn * 128 + cw0) = pack8(a, b);
            asm volatile("" ::: "memory"); }
        return false;
    }
};
struct EpiFfnOut {
    const h16* X1h; const float* gain; float* out; float* SSQ2; unsigned* cnt;
    __device__ __forceinline__ bool operator()(AccT& acc, const pg8::Unit& u, int wr, int wc, int fr, int fq) const {
        EPI_ROWS(u);
        EPI_FOR { const size_t row = (size_t)(row0 + ai * 128 + m * 16); float ss = 0.f;
#pragma unroll
            for (int bj = 0; bj < 2; ++bj) { const size_t o = row * DM + u.pn * 256 + cw0 + bj * 128; const h16x8 xh = *(const h16x8*)(X1h + o);
                f32x4 a = acc[ai][bj][m][0], b = acc[ai][bj][m][1];
#pragma unroll
                for (int j = 0; j < 4; ++j) { a[j] += (float)xh[j]; b[j] += (float)xh[4 + j]; }
                acc[ai][bj][m][0] = a; acc[ai][bj][m][1] = b;
                ss += (a[0] * a[0] + a[1] * a[1]) + (a[2] * a[2] + a[3] * a[3]) + (b[0] * b[0] + b[1] * b[1]) + (b[2] * b[2] + b[3] * b[3]); }
            ss += __shfl_xor(ss, 16); ss += __shfl_xor(ss, 32);
            if (fq == 0) __hip_atomic_store(SSQ2 + row * 16 + u.pn * 4 + wc, ss, __ATOMIC_RELAXED, __HIP_MEMORY_SCOPE_AGENT);
            asm volatile("" ::: "memory"); }
        asm volatile("s_waitcnt vmcnt(0)" ::: "memory");
        unsigned* cw = cnt + 64 * u.pm;
        if ((threadIdx.x & 63) == 0) __hip_atomic_fetch_add(cw, 1u, __ATOMIC_RELAXED, __HIP_MEMORY_SCOPE_AGENT);
        if (threadIdx.x < 64) {
            unsigned spins = 0;
            while ((unsigned)__builtin_amdgcn_readfirstlane(__hip_atomic_load(cw, __ATOMIC_RELAXED, __HIP_MEMORY_SCOPE_AGENT)) < 32u) { __builtin_amdgcn_s_sleep(2); if (++spins > (1u << 22)) break; }
            __builtin_amdgcn_fence(__ATOMIC_ACQUIRE, "agent");
            asm volatile("s_waitcnt vmcnt(0)" ::: "memory");
        }
        asm volatile("" ::: "memory"); __builtin_amdgcn_s_barrier(); asm volatile("" ::: "memory");
        EPI_FOR { const size_t row = (size_t)(row0 + ai * 128 + m * 16);
            float tot = 0.f;
#pragma unroll
            for (int i = 0; i < 16; ++i) tot += __hip_atomic_load(SSQ2 + row * 16 + i, __ATOMIC_RELAXED, __HIP_MEMORY_SCOPE_AGENT);
            const float rstd = rsqrtf(tot * (1.f / DM) + EPS);
#pragma unroll
            for (int bj = 0; bj < 2; ++bj) { const int col = u.pn * 256 + cw0 + bj * 128; const size_t o = row * DM + col;
                const f32x4 g0 = *(const f32x4*)(gain + col), g1 = *(const f32x4*)(gain + col + 4);
                __builtin_nontemporal_store(acc[ai][bj][m][0] * rstd * g0, (f32x4*)(out + o)); __builtin_nontemporal_store(acc[ai][bj][m][1] * rstd * g1, (f32x4*)(out + o + 4)); }
            asm volatile("" ::: "memory"); }
        return false;
    }
};

constexpr int S5T = 32, S5K = 640, S5ROWS = 512;
__device__ __forceinline__ void s5_prep_part(const CAS Params& p, int g, int part, h16* BtMain, h16* BtSt, LAS unsigned char* lds) {
    LAS float* lp = (LAS float*)lds;
    LAS float* G0 = lp + 33 * 128;
    LAS float* Cc = G0 + 2048;
    LAS float* Kt = Cc + 2048;
    int tid_ = threadIdx.x; asm volatile("" : "+v"(tid_));
    const int tid = tid_;
    __syncthreads();
    if (tid < NP) {
        const int pp = tid;
        const float dt = __expf(p.log_dt[g]);
        const float ar = p.a_re[g * NP + pp], ai = p.a_im[g * NP + pp];
        const float mag = __expf(ar * dt);
        float s, c; sincos_big(ai * dt, s, c);
        const float lbr = mag * c, lbi = mag * s;
        const float nr = lbr - 1.f, ni = lbi, den = ar * ar + ai * ai;
        const float fr = (nr * ar + ni * ai) / den, fi = (ni * ar - nr * ai) / den;
        float cr = 1.f, ci = 0.f;
        for (int d = 0; d <= S5T; ++d) { lp[(d * 2) * 64 + pp] = cr; lp[(d * 2 + 1) * 64 + pp] = ci; const float t = cr * lbr - ci * lbi; ci = cr * lbi + ci * lbr; cr = t; }
        for (int c2 = 0; c2 < GC; ++c2) { const float br = p.b_re[((size_t)g * NP + pp) * GC + c2], bi = p.b_im[((size_t)g * NP + pp) * GC + c2];
            G0[(pp * 16 + c2) * 2] = fr * br - fi * bi; G0[(pp * 16 + c2) * 2 + 1] = fr * bi + fi * br; }
    }
    for (int i = tid; i < GC * NP; i += 512) { Cc[2 * i] = p.c_re[(size_t)g * GC * NP + i]; Cc[2 * i + 1] = p.c_im[(size_t)g * GC * NP + i]; }
    __syncthreads();
    { const int c = (tid >> 4) & 15, c1 = tid & 15, dh = tid >> 8;
      const float dsk = p.d_skip[g * GC + c];
      float accd[16];
#pragma unroll
      for (int dd = 0; dd < 16; ++dd) accd[dd] = 0.f;
#pragma unroll
      for (int h = 0; h < 2; ++h) {
          f32x4 wr4[8], wi4[8];
#pragma unroll
          for (int q = 0; q < 8; ++q)
#pragma unroll
              for (int e = 0; e < 4; ++e) { const int pp = 32 * h + 4 * q + e; const float cr = Cc[(c * 64 + pp) * 2], ci = Cc[(c * 64 + pp) * 2 + 1], gr = G0[(pp * 16 + c1) * 2], gi = G0[(pp * 16 + c1) * 2 + 1];
                  wr4[q][e] = cr * gr - ci * gi; wi4[q][e] = -(cr * gi + ci * gr); }
#pragma unroll
          for (int dd = 0; dd < 16; ++dd) { const int d = dh * 16 + dd;
              const LAS f32x4* lr4 = (const LAS f32x4*)(lp + (d * 2) * 64) + 8 * h; const LAS f32x4* li4 = (const LAS f32x4*)(lp + (d * 2 + 1) * 64) + 8 * h;
              f32x4 s0 = (f32x4){0.f, 0.f, 0.f, 0.f}, s1 = s0, s2 = s0, s3 = s0;
#pragma unroll
              for (int q = 0; q < 8; q += 2) { s0 += lr4[q] * wr4[q]; s1 += li4[q] * wi4[q]; s2 += lr4[q + 1] * wr4[q + 1]; s3 += li4[q + 1] * wi4[q + 1]; }
              const f32x4 s = (s0 + s1) + (s2 + s3);
              accd[dd] += (s[0] + s[1]) + (s[2] + s[3]);
              asm volatile("" ::: "memory"); }
      }
#pragma unroll
      for (int dd = 0; dd < 16; ++dd) { const int d = dh * 16 + dd; Kt[(d * 16 + c) * 16 + c1] = accd[dd] + ((d == 0 && c == c1) ? dsk : 0.f); } }
    __syncthreads();
    h16* bm = BtMain + (size_t)g * S5ROWS * S5K;
    for (int pc = tid; pc < 128 * 80; pc += 512) {
        const int n = part * 128 + pc / 80, k8 = (pc % 80) * 8, tau = n >> 4, c = n & 15;
        float v[8];
        if (k8 < 512) { const int sg = k8 >> 4, c0 = k8 & 15;
#pragma unroll
            for (int j = 0; j < 8; ++j) v[j] = sg <= tau ? Kt[((tau - sg) * 16 + c) * 16 + c0 + j] : 0.f;
        } else { const int q0 = k8 - 512; const bool im = q0 >= 64; const int p0 = q0 & 63;
#pragma unroll
            for (int j = 0; j < 8; ++j) { const int pp = p0 + j; const float cr = Cc[(c * 64 + pp) * 2], ci = Cc[(c * 64 + pp) * 2 + 1], lr = lp[((tau + 1) * 2) * 64 + pp], li = lp[((tau + 1) * 2 + 1) * 64 + pp];
                v[j] = im ? -(cr * li + ci * lr) : (cr * lr - ci * li); }
        }
        u32x4 o; o.x = pk2h(v[0], v[1]); o.y = pk2h(v[2], v[3]); o.z = pk2h(v[4], v[5]); o.w = pk2h(v[6], v[7]);
        *(u32x4*)(bm + (size_t)n * S5K + k8) = o;
    }
    h16* bs = BtSt + (size_t)g * 256 * 512;
    if (part < 2) for (int pc = tid; pc < 64 * 64; pc += 512) {
        const int n = part * 64 + (pc >> 6), k8 = (pc & 63) * 8, sg = k8 >> 4, c0 = k8 & 15;
        float v[8];
        if (n < 128) { const int pp = n & 63; const bool im = n >= 64; const float lr = lp[((S5T - 1 - sg) * 2) * 64 + pp], li = lp[((S5T - 1 - sg) * 2 + 1) * 64 + pp];
#pragma unroll
            for (int j = 0; j < 8; ++j) { const float gr = G0[(pp * 16 + c0 + j) * 2], gi = G0[(pp * 16 + c0 + j) * 2 + 1]; v[j] = im ? (lr * gi + li * gr) : (lr * gr - li * gi); }
        } else {
#pragma unroll
            for (int j = 0; j < 8; ++j) v[j] = 0.f;
        }
        u32x4 o; o.x = pk2h(v[0], v[1]); o.y = pk2h(v[2], v[3]); o.z = pk2h(v[4], v[5]); o.w = pk2h(v[6], v[7]);
        *(u32x4*)(bs + (size_t)n * 512 + k8) = o;
    }
    __syncthreads();
}
__device__ __forceinline__ void s5_scan_one(const CAS Params& p, const float* Sbuf, h16* Up, LAS unsigned char* lds, int b, int g) {
    int tid_ = threadIdx.x; asm volatile("" : "+v"(tid_));
    const int lane = tid_ & 63, seg = tid_ >> 6;
    LAS float* ex = (LAS float*)lds;
    const float dt = __expf(p.log_dt[g]);
    const float ar = p.a_re[g * NP + lane], ai = p.a_im[g * NP + lane];
    const float mag = __expf(ar * dt);
    float s, c; sincos_big(ai * dt, s, c);
    float lr = mag * c, li = mag * s;
#pragma unroll
    for (int i = 0; i < 5; ++i) { const float t = lr * lr - li * li; li = 2.f * lr * li; lr = t; }
    float Lr = lr, Li = li;
#pragma unroll
    for (int i = 0; i < 5; ++i) { const float t = Lr * Lr - Li * Li; Li = 2.f * Lr * Li; Lr = t; }
    const float* sp = Sbuf + ((size_t)g * S5ROWS + (size_t)b * 256 + seg * 32) * 128 + lane;
    h16* hp = Up + ((size_t)g * S5ROWS + (size_t)b * 256 + seg * 32) * S5K + 512 + lane;
    float hr = 0.f, hi = 0.f;
    for (int k0 = 0; k0 < 32; k0 += 16) {
        float sr[16], si[16];
#pragma unroll
        for (int j = 0; j < 16; ++j) { sr[j] = sp[(size_t)(k0 + j) * 128]; si[j] = sp[(size_t)(k0 + j) * 128 + 64]; }
#pragma unroll
        for (int j = 0; j < 16; ++j) { const float nr = lr * hr - li * hi + sr[j], ni = lr * hi + li * hr + si[j]; hr = nr; hi = ni; }
    }
    __syncthreads();
    ex[(seg * 64 + lane) * 2] = hr; ex[(seg * 64 + lane) * 2 + 1] = hi;
    __syncthreads();
    hr = 0.f; hi = 0.f;
    for (int s2 = 0; s2 < seg; ++s2) { const float er = ex[(s2 * 64 + lane) * 2], ei = ex[(s2 * 64 + lane) * 2 + 1];
        const float nr = Lr * hr - Li * hi + er, ni = Lr * hi + Li * hr + ei; hr = nr; hi = ni; }
    for (int k0 = 0; k0 < 32; k0 += 16) {
        float sr[16], si[16];
#pragma unroll
        for (int j = 0; j < 16; ++j) { sr[j] = sp[(size_t)(k0 + j) * 128]; si[j] = sp[(size_t)(k0 + j) * 128 + 64]; }
#pragma unroll
        for (int j = 0; j < 16; ++j) {
            hp[(size_t)(k0 + j) * S5K] = (h16)hr; hp[(size_t)(k0 + j) * S5K + 64] = (h16)hi;
            const float nr = lr * hr - li * hi + sr[j], ni = lr * hi + li * hr + si[j]; hr = nr; hi = ni;
        }
    }
    __syncthreads();
}
struct SchedOne { bool ok; const char* A; const char* B; int pm, pn, tag;
    __device__ __forceinline__ bool next(int i, pg8::Unit& u) const { if (!ok || i != 0) return false; u.A = A; u.B = B; u.pm = pm; u.pn = pn; u.tag = tag; return true; } };
struct EpiS5State {
    float* Sbuf;
    __device__ __forceinline__ bool operator()(AccT& acc, const pg8::Unit& u, int wr, int wc, int fr, int fq) const {
        EPI_ROWS(u);
        EPI_FOR { float* sp = Sbuf + ((size_t)u.tag * S5ROWS + (size_t)(row0 + ai * 128 + m * 16)) * 128 + cw0; *(f32x4*)sp = acc[ai][0][m][0]; *(f32x4*)(sp + 4) = acc[ai][0][m][1]; }
        return false;
    }
};
struct EpiS5Main {
    h16* YS;
    __device__ __forceinline__ bool operator()(AccT& acc, const pg8::Unit& u, int wr, int wc, int fr, int fq) const {
        EPI_ROWS(u);
        EPI_FOR { const int row = row0 + ai * 128 + m * 16; const size_t tok0 = (size_t)(row >> 8) * SEQ + (size_t)(row & 255) * S5T;
#pragma unroll
            for (int bj = 0; bj < 2; ++bj) { const int n = u.pn * 256 + cw0 + bj * 128, tau = n >> 4, c = n & 15;
                f32x4 a = acc[ai][bj][m][0], b = acc[ai][bj][m][1];
#pragma unroll
                for (int j = 0; j < 4; ++j) { a[j] = gelu_tanh(a[j]); b[j] = gelu_tanh(b[j]); }
                *(u32x4*)(YS + (tok0 + tau) * DM + u.tag * GC + c) = pack8(a, b); } }
        return false;
    }
};

__device__ __forceinline__ void tr_item(const float* __restrict__ W, int ldw, int c0, int ncols, int K, h16* WT, int r0, const float* kscale, LAS float* scr, int item, int lane) {
    const int nblk = (ncols + 31) >> 5, kb = item / nblk, nb = item % nblk, k0 = 64 * kb, n0 = 32 * nb;
    const int cq = 4 * (lane & 7), nn = n0 + cq;
    f32x4 v[8];
#pragma unroll
    for (int i = 0; i < 8; ++i) { const int kk = 8 * i + (lane >> 3); v[i] = nn < ncols ? __builtin_nontemporal_load((const f32x4*)(W + (size_t)(k0 + kk) * ldw + c0 + nn)) : (f32x4){0.f, 0.f, 0.f, 0.f}; }
#pragma unroll
    for (int i = 0; i < 8; ++i) { const int kk = 8 * i + (lane >> 3); f32x4 x = v[i]; if (kscale) x = x * kscale[k0 + kk];
        scr[kk * 33 + cq] = x[0]; scr[kk * 33 + cq + 1] = x[1]; scr[kk * 33 + cq + 2] = x[2]; scr[kk * 33 + cq + 3] = x[3]; }
    asm volatile("s_waitcnt lgkmcnt(0)" ::: "memory");
    const int c = lane & 7;
#pragma unroll
    for (int j = 0; j < 4; ++j) { const int n = (lane >> 3) + 8 * j; const LAS float* s = scr + (8 * c) * 33 + n;
        u32x4 o; o.x = pk2h(s[0 * 33], s[1 * 33]); o.y = pk2h(s[2 * 33], s[3 * 33]); o.z = pk2h(s[4 * 33], s[5 * 33]); o.w = pk2h(s[6 * 33], s[7 * 33]);
        *(u32x4*)(WT + (size_t)(r0 + n0 + n) * K + k0 + 8 * c) = o; }
    asm volatile("s_waitcnt lgkmcnt(0)" ::: "memory");
}
__device__ __forceinline__ void prologue_weights(const CAS Params& p, unsigned char* ws, LAS unsigned char* lds, int part, int gw, int NGW, int lo = 0, int hi = 1 << 30) {
    int tid_ = threadIdx.x; asm volatile("" : "+v"(tid_));
    const int lane = tid_ & 63, wv = __builtin_amdgcn_readfirstlane(tid_ >> 6);
    LAS float* scr = (LAS float*)(lds + wv * 16384);
    h16* Win = (h16*)(ws + WS_WIN); h16* Wga = (h16*)(ws + WS_WGA); h16* Wgb = (h16*)(ws + WS_WGB); h16* Wglu = (h16*)(ws + WS_WGLU);
    h16* Wa = (h16*)(ws + WS_WA); h16* Wb = (h16*)(ws + WS_WB); h16* Wout = (h16*)(ws + WS_WOUT); h16* Wfi = (h16*)(ws + WS_WFI); h16* Wfo = (h16*)(ws + WS_WFO);
    constexpr int I_IN = 16 * 115, I_SQ = 16 * 32, I_FI = 44 * 64, I_FO = 44 * 32;
    if (part == 0) { for (int it = gw; it < I_IN; it += NGW) tr_item(p.w_in, INW, 0, C_GA, DM, Win, 0, nullptr, scr, it, lane); return; }
    constexpr int NITEMS = 6 * I_SQ + I_FI + I_FO;
    const int iend = hi < NITEMS ? hi : NITEMS;
    for (int it = lo + gw; it < iend; it += NGW) {
        int r = it;
        if (r < I_SQ) { tr_item(p.w_in, INW, C_GA, DM, DM, Wga, 0, nullptr, scr, r, lane); continue; } r -= I_SQ;
        if (r < I_SQ) { tr_item(p.w_in, INW, C_GB, DM, DM, Wgb, 0, nullptr, scr, r, lane); continue; } r -= I_SQ;
        if (r < I_SQ) { tr_item(p.w_glu, DM, 0, DM, DM, Wglu, 0, nullptr, scr, r, lane); continue; } r -= I_SQ;
        if (r < I_SQ) { tr_item(p.w_a, DM, 0, DM, DM, Wa, 0, nullptr, scr, r, lane); continue; } r -= I_SQ;
        if (r < I_SQ) { tr_item(p.w_b, DM, 0, DM, DM, Wb, 0, nullptr, scr, r, lane); continue; } r -= I_SQ;
        if (r < I_SQ) { tr_item(p.w_out, DM, 0, DM, DM, Wout, 0, nullptr, scr, r, lane); continue; } r -= I_SQ;
        if (r < I_FI) { const int sub = r >> 6, j = sub >> 1, hf = sub & 1; tr_item(p.w_ffn_in, 2 * FF, hf * FF + j * 128, 128, DM, Wfi, j * 256 + hf * 128, p.norm2_g, scr, r & 63, lane); continue; } r -= I_FI;
        tr_item(p.w_ffn_out, DM, 0, DM, FF, Wfo, 0, nullptr, scr, r, lane);
    }
}

__device__ __forceinline__ int wave_id_() { int t = threadIdx.x; asm volatile("" : "+v"(t)); return t >> 6; }
__device__ __forceinline__ unsigned char* ws_opq_(unsigned char* w) { unsigned long long u = (unsigned long long)w; asm volatile("" : "+s"(u)); return (unsigned char*)(__attribute__((address_space(1))) unsigned char*)u; }
__global__ void __launch_bounds__(512, 2) mk_fwd(Params p_) {
    (void)p_;
    const CAS Params& p = *(const CAS Params*)__builtin_amdgcn_kernarg_segment_ptr();
    extern __shared__ __attribute__((aligned(16))) unsigned char lds_raw[];
    LAS unsigned char* lds = (LAS unsigned char*)lds_raw;
    float* sm = (float*)lds_raw;
    unsigned char* ws = p.ws;
#define WSO_ ws_opq_(ws)
    const int G = gridDim.x, bx = blockIdx.x;
    { volatile LAS unsigned* st0 = (volatile LAS unsigned*)(lds + LDS_BYTES - 64); if (threadIdx.x < 16) st0[threadIdx.x] = 0u; }
    __syncthreads();
    const XcdBarrier xbar = xcd_barrier_post((unsigned*)(ws + WS_CTL) + 4096, (volatile LAS unsigned*)(lds + LDS_BYTES - 64));

    if (((bx >> 3) & 1) == 0) {
        for (int v = bx; v < 4 * NG; v += G) s5_prep_part(p, v >> 2, v & 3, (h16*)(ws + WS_BTM), (h16*)(ws + WS_BTS), lds);
        prologue_weights(p, ws, lds, 0, bx * 8 + wave_id_(), G * 8);
        rmsnorm_rows_h16(p.x, p.norm1_g, ((h16*)(WSO_ + WS_H)));
    } else {
        rmsnorm_rows_h16(p.x, p.norm1_g, ((h16*)(WSO_ + WS_H)));
        prologue_weights(p, ws, lds, 0, bx * 8 + wave_id_(), G * 8);
        for (int v = bx; v < 4 * NG; v += G) s5_prep_part(p, v >> 2, v & 3, (h16*)(ws + WS_BTM), (h16*)(ws + WS_BTS), lds);
    }
    xcd_barrier(xbar);
    { pg8::SchedStd S; S.so.init(M, NWIN, G, bx); S.A = (const char*)((h16*)(WSO_ + WS_H)); S.B = ((const char*)(WSO_ + WS_WIN)); S.tstepA = (size_t)256 * DM * 2; S.tstepB = (size_t)256 * DM * 2;
      pg8::gemm_phase(lds, pg8::Geo{DM, DM, DM / 64}, S, EpiInProj{((h16*)(WSO_ + WS_U)), ((h16*)p.out), ((h16*)(WSO_ + WS_K)), ((h16*)(WSO_ + WS_V)), ((h16*)(WSO_ + WS_QI)), ((h16*)(WSO_ + WS_KI)), ((float*)(WSO_ + WS_WI))}); }
    if (G == 256 && bx >= 192) prologue_weights(p, ws, lds, 1, (bx - 192) * 8 + wave_id_(), 64 * 8, 0, 4096);
    xcd_barrier(xbar);
    { float* Sbuf = (float*)((unsigned char*)p.out + 32 * MiB);
      if (G == 256) {
        const int xl = bx & 7, l = bx >> 3; const bool first = l < 16; const int s = xl * 16 + (l & 15), g = s >> 1, rt = s & 1;
        unsigned* flag = (unsigned*)(ws + WS_CTL) + 12288 + s;
        if (first) {
            { SchedOne S; S.ok = true; S.A = (const char*)((h16*)(WSO_ + WS_U)) + ((size_t)g * 512 + rt * 256) * 640 * 2; S.B = (const char*)(ws + WS_BTS) + (size_t)g * 256 * 512 * 2; S.pm = rt; S.pn = 0; S.tag = g;
              pg8::gemm_phase(lds, pg8::Geo{640, 512, 8}, S, EpiS5State{Sbuf}); }
            s5_scan_one(p, Sbuf, ((h16*)(WSO_ + WS_U)), lds, rt, g);
            asm volatile("s_waitcnt vmcnt(0)" ::: "memory");
            __syncthreads();
            if (threadIdx.x == 0) { __builtin_amdgcn_fence(__ATOMIC_RELEASE, "agent"); __hip_atomic_store(flag, 1u, __ATOMIC_RELAXED, __HIP_MEMORY_SCOPE_AGENT); __builtin_amdgcn_fence(__ATOMIC_ACQUIRE, "agent"); }
            __syncthreads();
        } else {
            prologue_weights(p, ws, lds, 1, (xl * 16 + (l - 16)) * 8 + wave_id_(), 128 * 8, 4096);
            if (threadIdx.x == 0) { unsigned sp = 0; while (__hip_atomic_load(flag, __ATOMIC_RELAXED, __HIP_MEMORY_SCOPE_AGENT) == 0u) { __builtin_amdgcn_s_sleep(2); if (++sp > (1u << 22)) break; }
                __builtin_amdgcn_fence(__ATOMIC_ACQUIRE, "agent"); asm volatile("s_waitcnt vmcnt(0)" ::: "memory"); }
            __syncthreads();
        }
        { SchedOne S; S.ok = true; const int pn = first ? 0 : 1; S.A = (const char*)((h16*)(WSO_ + WS_U)) + ((size_t)g * 512 + rt * 256) * 640 * 2; S.B = (const char*)(ws + WS_BTM) + ((size_t)g * 512 + pn * 256) * 640 * 2; S.pm = rt; S.pn = pn; S.tag = g;
          pg8::gemm_phase(lds, pg8::Geo{640, 640, 10}, S, EpiS5Main{((h16*)(WSO_ + WS_YS))}); }
      } else {
      const int vb = bx;
      { SchedOne S; S.ok = vb < 128; const int g = vb >> 1, rt = vb & 1; S.A = (const char*)((h16*)(WSO_ + WS_U)) + ((size_t)g * 512 + rt * 256) * 640 * 2; S.B = (const char*)(ws + WS_BTS) + (size_t)g * 256 * 512 * 2; S.pm = rt; S.pn = 0; S.tag = g;
        pg8::gemm_phase(lds, pg8::Geo{640, 512, 8}, S, EpiS5State{Sbuf}); }
      if (vb < 128) s5_scan_one(p, Sbuf, ((h16*)(WSO_ + WS_U)), lds, vb & 1, vb >> 1);
      else prologue_weights(p, ws, lds, 1, (vb - 128) * 8 + wave_id_(), (G - 128) * 8, 0);
      xcd_barrier(xbar);
      { SchedOne S; S.ok = vb < 256; const int g = vb >> 2, rt = (vb >> 1) & 1, pn = vb & 1; S.A = (const char*)((h16*)(WSO_ + WS_U)) + ((size_t)g * 512 + rt * 256) * 640 * 2; S.B = (const char*)(ws + WS_BTM) + ((size_t)g * 512 + pn * 256) * 640 * 2; S.pm = rt; S.pn = pn; S.tag = g;
        pg8::gemm_phase(lds, pg8::Geo{640, 640, 10}, S, EpiS5Main{((h16*)(WSO_ + WS_YS))}); }
      } }
    xcd_barrier(xbar);
    { pg8::SchedStd S; S.so.init(M, DM, G, bx); S.A = (const char*)((h16*)(WSO_ + WS_YS)); S.B = ((const char*)(WSO_ + WS_WGLU)); S.tstepA = (size_t)256 * DM * 2; S.tstepB = (size_t)256 * DM * 2;
      pg8::gemm_phase(lds, pg8::Geo{DM, DM, DM / 64}, S, EpiGlu{((h16*)(WSO_ + WS_YS)), ((h16*)((unsigned char*)p.out + 32 * MiB))}); }
    xcd_barrier(xbar);
    scores_phase(((h16*)(WSO_ + WS_QI)), ((h16*)(WSO_ + WS_KI)), ((float*)(WSO_ + WS_WI)), ((h16*)(WSO_ + WS_SC)), lds);
    xcd_barrier(xbar);
    select_phase2(((h16*)(WSO_ + WS_SC)), ((unsigned short*)(WSO_ + WS_IDX)), lds);
    xcd_barrier(xbar);
    attn_phase(((h16*)p.out), ((h16*)(WSO_ + WS_K)), ((h16*)(WSO_ + WS_V)), ((unsigned short*)(WSO_ + WS_IDX)), ((h16*)(WSO_ + WS_YB)), lds);
    xcd_barrier(xbar);
    { pg8::StaticOrder so; so.init(M, DM, G, bx); int pm = 0, pn = 0; const bool ok = so.next(0, pm, pn);
      const size_t ta = (size_t)pm * 256 * DM * 2, tb = (size_t)pn * 256 * DM * 2;
      pg8::SchedSeg4 S; S.pm = pm; S.pn = pn; S.ok = ok; S.aH = (const char*)((h16*)(WSO_ + WS_H)) + ta; S.dYA = (const char*)((h16*)((unsigned char*)p.out + 32 * MiB)) - (const char*)((h16*)(WSO_ + WS_H)); S.dYB = (const char*)((h16*)(WSO_ + WS_YB)) - (const char*)((h16*)(WSO_ + WS_H)); S.bW = ((const char*)(WSO_ + WS_WGA)) + tb; S.bstep = (long)(2 * MiB);
      pg8::gemm_phase(lds, pg8::Geo{DM, DM, DM / 64}, S, EpiMerge{((h16*)(WSO_ + WS_SA)), ((h16*)(WSO_ + WS_SB)), ((h16*)(WSO_ + WS_MG))}); }
    xcd_barrier(xbar);
    { pg8::SchedStd S; S.so.init(M, DM, G, bx); S.A = (const char*)((h16*)(WSO_ + WS_MG)); S.B = ((const char*)(WSO_ + WS_WOUT)); S.tstepA = (size_t)256 * DM * 2; S.tstepB = (size_t)256 * DM * 2;
      pg8::gemm_phase(lds, pg8::Geo{DM, DM, DM / 64}, S, EpiWout{p.x, ((h16*)(WSO_ + WS_H)), ((float*)(WSO_ + WS_SSQ))}); }
    xcd_barrier(xbar);
    { pg8::SchedStd S; S.so.init(M, 2 * FF, G, bx); S.A = (const char*)((h16*)(WSO_ + WS_H)); S.B = ((const char*)(WSO_ + WS_WFI)); S.tstepA = (size_t)256 * DM * 2; S.tstepB = (size_t)256 * DM * 2;
      LAS float* rtab = (LAS float*)(lds + 131072);
      { int tid2 = threadIdx.x; asm volatile("" : "+v"(tid2));
        for (int e = tid2; e < 8 * 256; e += 512) { const int ui = e >> 8, r = e & 255; int pm, pn;
            if (S.so.next(ui, pm, pn)) { const float* sq = ((float*)(WSO_ + WS_SSQ)) + ((size_t)pm * 256 + r) * 16;
                const f32x4 s0 = *(const f32x4*)sq, s1 = *(const f32x4*)(sq + 4), s2 = *(const f32x4*)(sq + 8), s3 = *(const f32x4*)(sq + 12); const f32x4 st = (s0 + s1) + (s2 + s3);
                rtab[e] = rsqrtf(((st[0] + st[1]) + (st[2] + st[3])) * (1.f / DM) + EPS); } }
        __syncthreads(); }
      pg8::gemm_phase(lds, pg8::Geo{DM, DM, DM / 64}, S, EpiFfnIn{rtab, ((h16*)(WSO_ + WS_HID))}); }
    xcd_barrier(xbar);
    { pg8::SchedStd S; S.so.init(M, DM, G, bx); S.A = (const char*)((h16*)(WSO_ + WS_HID)); S.B = ((const char*)(WSO_ + WS_WFO)); S.tstepA = (size_t)256 * FF * 2; S.tstepB = (size_t)256 * FF * 2;
      pg8::gemm_phase(lds, pg8::Geo{FF, FF, FF / 64}, S, EpiFfnOut{((h16*)(WSO_ + WS_H)), p.norm_f_g, p.out, ((float*)(WSO_ + WS_SSQ)) + (size_t)M * 16, (unsigned*)(ws + WS_CTL) + 8192}); }
}

extern "C" void kernel_launch(void* const* d_in, const int* in_sizes, int n_in, void* d_out, int out_size, void* d_ws, size_t ws_size, hipStream_t stream) {
    static int grid = 0;
    if (grid == 0) {
        int dev = 0, cus = 0, per_cu = 0;
        (void)hipGetDevice(&dev);
        (void)hipDeviceGetAttribute(&cus, hipDeviceAttributeMultiprocessorCount, dev);
        if (hipFuncSetAttribute((const void*)mk_fwd, hipFuncAttributeMaxDynamicSharedMemorySize, LDS_BYTES) != hipSuccess) fprintf(stderr, "kernel_launch: hipFuncSetAttribute failed\n");
        if (hipOccupancyMaxActiveBlocksPerMultiprocessor(&per_cu, (const void*)mk_fwd, 512, LDS_BYTES) != hipSuccess || per_cu < 1) { fprintf(stderr, "kernel_launch: occupancy query says %d\n", per_cu); per_cu = 1; }
        (void)hipGetLastError();
        grid = cus;
        if (ws_size < WS_END) fprintf(stderr, "kernel_launch: workspace too small: %zu < %zu\n", ws_size, (size_t)WS_END);
    }
    (void)hipMemsetAsync((char*)d_ws + WS_CTL, 0, 65536, stream);
    Params p{};
    const float** f = (const float**)&p;
    for (int i = 0; i < 19; ++i) f[i] = (const float*)d_in[i];
    p.out = (float*)d_out; p.ws = (unsigned char*)d_ws;
    void* args[] = {&p};
    hipError_t e = hipLaunchCooperativeKernel((const void*)mk_fwd, dim3(grid), dim3(512), args, LDS_BYTES, stream);
    if (e != hipSuccess) {
        fprintf(stderr, "cooperative launch failed: %s (grid %d); launching the same grid plainly\n", hipGetErrorString(e), grid);
        (void)hipGetLastError();
        hipLaunchKernelGGL(mk_fwd, dim3(grid), dim3(512), LDS_BYTES, stream, p);
    }
}
```

```cpp
#include <hip/hip_runtime.h>
#include <cstdio>
#include <cstdint>
typedef _Float16 h16;
typedef _Float16 h16x8 __attribute__((ext_vector_type(8)));
typedef float f32x4 __attribute__((ext_vector_type(4)));
typedef unsigned u32x4 __attribute__((ext_vector_type(4)));
#define LAS __attribute__((address_space(3)))
#define CAS __attribute__((address_space(4)))

constexpr int BATCH = 2, SEQ = 8192, DM = 1024, M = BATCH * SEQ;
constexpr int NG = 64, GC = 16, NP = 64;
constexpr int NH = 8, HD = 128, NKV = 2, KVW = 256;
constexpr int IH = 16, IDIM = 64;
constexpr int TOPK = 256, CH = 64, NCH = SEQ / CH;
constexpr int FF = 2816;
constexpr int INW = 5712;
constexpr float EPS = 1e-6f;
constexpr float LN_THETA = 13.122363377404328f;
constexpr int C_U = 0, C_Q = 1024, C_K = 2048, C_V = 2304, C_QI = 2560, C_KI = 3584, C_WI = 3648, C_GA = 3664, C_GB = 4688;
constexpr int NWIN = 3840;

constexpr size_t MiB = 1u << 20;
constexpr size_t WS_CTL = 0, WS_TAB = 1 * MiB;
constexpr size_t WS_K = 3 * MiB, WS_V = 11 * MiB, WS_QI = 19 * MiB, WS_KI = 51 * MiB, WS_WI = 53 * MiB, WS_IDX = 54 * MiB;
constexpr size_t WS_H = 62 * MiB;
constexpr size_t WS_SC = 94 * MiB;
constexpr size_t WS_U = 94 * MiB, WS_YS = 134 * MiB, WS_WIN = 134 * MiB, WS_BTM = 166 * MiB, WS_BTS = 206 * MiB;
constexpr size_t WS_YB = 94 * MiB, WS_SA = 126 * MiB, WS_SB = 158 * MiB, WS_MG = 190 * MiB;
constexpr size_t WS_HID = 94 * MiB;
constexpr size_t WS_WGA = 223 * MiB, WS_WGB = 225 * MiB, WS_WA = 227 * MiB, WS_WB = 229 * MiB, WS_WGLU = 231 * MiB,     WS_WOUT = 233 * MiB, WS_WFI = 235 * MiB, WS_WFO = 246 * MiB;
constexpr size_t WS_SSQ = 252 * MiB, WS_END = 254 * MiB;
constexpr size_t SC_BATCH = (size_t)4096 * 8256;
constexpr int LDS_BYTES = 147456;

struct Params {
    const float *x, *norm1_g, *w_in, *a_re, *a_im, *log_dt, *b_re, *b_im, *c_re, *c_im, *d_skip, *w_glu, *w_a, *w_b, *w_out, *norm2_g, *w_ffn_in, *w_ffn_out, *norm_f_g;
    float* out; unsigned char* ws;
};

__device__ __forceinline__ float wave_sum(float v) {
#pragma unroll
    for (int o = 1; o < 64; o <<= 1) v += __shfl_xor(v, o);
    return v;
}
__device__ __forceinline__ float wave_max(float v) {
#pragma unroll
    for (int o = 1; o < 64; o <<= 1) v = fmaxf(v, __shfl_xor(v, o));
    return v;
}
__device__ __forceinline__ float sigmoidf_(float v) { return __builtin_amdgcn_rcpf(1.f + __expf(-v)); }
__device__ __forceinline__ float gelu_tanh(float v) {
    const float u2 = 1.5957691216057308f * (v + 0.044715f * v * v * v);
    return v * __builtin_amdgcn_rcpf(1.f + __expf(-u2));
}
__device__ __forceinline__ void sincos_big(float ang, float& s, float& c) {
    const double a = (double)ang;
    const double n = __builtin_rint(a * 0.15915494309189535);
    const float r = (float)(a - n * 6.283185307179586);
    s = __sinf(r); c = __cosf(r);
}
__device__ __forceinline__ unsigned pk2h(float lo, float hi) { return __builtin_bit_cast(unsigned, __builtin_amdgcn_cvt_pkrtz(lo, hi)); }
__device__ __forceinline__ u32x4 pack8(f32x4 a, f32x4 b) { u32x4 w; w.x = pk2h(a[0], a[1]); w.y = pk2h(a[2], a[3]); w.z = pk2h(b[0], b[1]); w.w = pk2h(b[2], b[3]); return w; }

namespace pg8 {
constexpr int BM = 256, BK = 64, HALF = 128, HTB = HALF * BK * 2, STAGE_BYTES = 8 * HTB, NXCD = 8, WGM = 8;
__host__ __device__ __forceinline__ int lds_byte(int r, int c) { const int st = (r >> 4) * 2 + (c >> 5), rr = r & 15, cc = c & 31, ob = rr * 64 + cc * 2; return st * 1024 + (ob ^ (((ob >> 9) & 1) << 5)); }
__host__ __device__ __forceinline__ void stage_rc(int b, int& R, int& C) { const int st = b / 1024, sb = b % 1024, swz = sb ^ (((sb >> 9) & 1) << 5); R = (st >> 1) * 16 + swz / 64; C = (st & 1) * 32 + (swz % 64) / 2; }
__host__ __device__ __forceinline__ int perm32(int rho) { const int n = rho >> 4, i = rho & 15; return 8 * (i >> 2) + 4 * n + (i & 3); }

struct Unit { const char* A; const char* B; int pm, pn, tag; };
struct StaticOrder {
    int nM, nN, nwg, G, c;
    __host__ __device__ __forceinline__ void init(int Mr, int N, int G_, int c_) { nM = Mr / BM; nN = N / BM; nwg = nM * nN; G = G_; c = c_; }
    __host__ __device__ __forceinline__ bool next(int i, int& pm, int& pn) const {
        const long L = (long)i * G + c; if (L >= nwg) return false;
        int wgid = (int)L; { const int q = nwg / NXCD, r = nwg % NXCD, xcd = wgid % NXCD, off = wgid / NXCD; wgid = (xcd < r ? xcd * (q + 1) : r * (q + 1) + (xcd - r) * q) + off; }
        const int nig = WGM * nN, gid = wgid / nig, fm = gid * WGM, gsz = (nM - fm) < WGM ? (nM - fm) : WGM;
        pm = fm + ((wgid % nig) % gsz); pn = (wgid % nig) / gsz; return true;
    }
};
struct SchedStd {
    StaticOrder so; const char* A; const char* B; size_t tstepA, tstepB;
    __device__ __forceinline__ bool next(int i, Unit& u) const { int pm, pn; if (!so.next(i, pm, pn)) return false; u.A = A + (size_t)pm * tstepA; u.B = B + (size_t)pn * tstepB; u.pm = pm; u.pn = pn; u.tag = i; return true; }
};
struct SchedSeg4 {
    int pm, pn; bool ok; const char* aH; long dYA, dYB; const char* bW; long bstep;
    __device__ __forceinline__ bool next(int i, Unit& u) const {
        if (!ok || i >= 4) return false;
        u.A = aH + (i == 2 ? dYA : 0l) + (i == 3 ? dYB : 0l); u.B = bW + (long)i * bstep; u.pm = pm; u.pn = pn; u.tag = i; return true;
    }
};
struct Geo { int lda, ldb, nt; };

template <class Epi, class Sched>
__device__ __forceinline__ void gemm_phase(LAS unsigned char* lds, const Geo G, const Sched& S, const Epi& E) {
    int tid_ = threadIdx.x; asm volatile("" : "+v"(tid_));
    const int tid = tid_, wid = __builtin_amdgcn_readfirstlane(tid >> 6), lane = tid & 63, wr = wid >> 2, wc = wid & 3, fr = lane & 15, fq = lane >> 4;
    const int nt = G.nt;
    unsigned voffA[2], voffB[2];
#pragma unroll
    for (int i = 0; i < 2; ++i) { int R, C; stage_rc(tid * 16 + i * 8192, R, C); const int Rb = (R & ~31) + perm32(R & 31);
        voffA[i] = (unsigned)(R * G.lda + C) * 2u; voffB[i] = (unsigned)(Rb * G.ldb + C) * 2u; }
    const size_t kstep = (size_t)(BK * 2);
    const size_t hstepA = (size_t)HALF * G.lda * 2, hstepB = (size_t)HALF * G.ldb * 2;
    const unsigned ldsw = (unsigned)wid * 1024u;
    const int aoff = lds_byte(wr * 64 + fr, fq * 8), boff = lds_byte(wc * 32 + fr, fq * 8);
#define PG8_SA(b, h) (((b) * 2 + (h)) * HTB)
#define PG8_SB(b, h) ((4 + (b) * 2 + (h)) * HTB)
#define PG8_STAGE(bufoff, gbase, voff) do { _Pragma("unroll") for (int _i = 0; _i < 2; ++_i) { unsigned vo_ = (voff)[_i]; asm volatile("" : "+v"(vo_));     \
        __builtin_amdgcn_global_load_lds((const unsigned*)((const char*)(gbase) + vo_), (LAS unsigned*)(lds + (bufoff) + ldsw + _i * 8192), 16, 0, 0); } } while (0)
#define PG8_LDA(dst, b, h) do { _Pragma("unroll") for (int m = 0; m < 4; ++m) _Pragma("unroll") for (int k = 0; k < 2; ++k) dst[m][k] = *(const LAS h16x8*)(lds + PG8_SA(b, h) + aoff + m * 2048 + k * 1024); } while (0)
#define PG8_LDB(dst, b, h) do { _Pragma("unroll") for (int n = 0; n < 2; ++n) _Pragma("unroll") for (int k = 0; k < 2; ++k) dst[n][k] = *(const LAS h16x8*)(lds + PG8_SB(b, h) + boff + n * 2048 + k * 1024); } while (0)
#define PG8_MMA(ai, bj, At, Bt) do { __builtin_amdgcn_s_setprio(1); _Pragma("unroll") for (int m = 0; m < 4; ++m) _Pragma("unroll") for (int n = 0; n < 2; ++n) _Pragma("unroll") for (int k = 0; k < 2; ++k) \
        acc[ai][bj][m][n] = __builtin_amdgcn_mfma_f32_16x16x32_f16(Bt[n][k], At[m][k], acc[ai][bj][m][n], 0, 0, 0); __builtin_amdgcn_s_setprio(0); } while (0)
#define PG8_WAIT_V(n) asm volatile("s_waitcnt vmcnt(" #n ")" ::: "memory")
#define PG8_WAIT_L(n) asm volatile("s_waitcnt lgkmcnt(" #n ")" ::: "memory")
#define PG8_BAR __builtin_amdgcn_s_barrier()
#define PG8_SCHED __builtin_amdgcn_sched_barrier(0)
#define PG8_ZERO() do { _Pragma("unroll") for (int a = 0; a < 2; ++a) _Pragma("unroll") for (int b = 0; b < 2; ++b) _Pragma("unroll") for (int m = 0; m < 4; ++m) _Pragma("unroll") for (int n = 0; n < 2; ++n) acc[a][b][m][n] = (f32x4){0.f, 0.f, 0.f, 0.f}; } while (0)
    Unit cur, nxt; int ui = 0;
    if (!S.next(0, cur)) return;
    f32x4 acc[2][2][4][2];
    PG8_ZERO();
    h16x8 At[4][2], B0[2][2], B1[2][2];
    const char* cA = cur.A; const char* cB = cur.B;
    PG8_STAGE(PG8_SB(0, 0), cB, voffB); PG8_STAGE(PG8_SB(0, 1), cB + hstepB, voffB); PG8_STAGE(PG8_SA(0, 0), cA, voffA); PG8_STAGE(PG8_SA(0, 1), cA + hstepA, voffA);
    if (wr == 1) PG8_BAR;
    PG8_WAIT_V(2); PG8_BAR;
    PG8_STAGE(PG8_SB(1, 0), cB + kstep, voffB); PG8_STAGE(PG8_SA(1, 0), cA + kstep, voffA); PG8_STAGE(PG8_SB(1, 1), cB + hstepB + kstep, voffB);
    PG8_WAIT_V(6); PG8_BAR;
    for (;;) {
        const bool has_next = S.next(ui + 1, nxt);
        const char* nA = has_next ? nxt.A : cA; const char* nB = has_next ? nxt.B : cB;
        for (int t = 0; t < nt; t += 2) {
            const bool last = (t == nt - 2);
            const char* a1 = cA + (size_t)(t + 1) * kstep;
            const char* a2 = last ? nA : cA + (size_t)(t + 2) * kstep; const char* b2 = last ? nB : cB + (size_t)(t + 2) * kstep;
            const char* a3 = a2 + kstep; const char* b3 = b2 + kstep;
            PG8_LDB(B0, 0, 0); PG8_LDB(B1, 0, 1); PG8_SCHED; PG8_LDA(At, 0, 0); PG8_STAGE(PG8_SA(1, 1), a1 + hstepA, voffA);
            PG8_WAIT_V(8); PG8_WAIT_L(0); PG8_BAR; PG8_MMA(0, 0, At, B0); PG8_MMA(0, 1, At, B1); PG8_BAR; PG8_SCHED;
            PG8_LDA(At, 0, 1); PG8_STAGE(PG8_SB(0, 0), b2, voffB); PG8_STAGE(PG8_SB(0, 1), b2 + hstepB, voffB); PG8_STAGE(PG8_SA(0, 0), a2, voffA);
            PG8_WAIT_V(8); PG8_WAIT_L(0); PG8_BAR; PG8_MMA(1, 0, At, B0); PG8_MMA(1, 1, At, B1); PG8_BAR; PG8_SCHED;
            PG8_LDB(B0, 1, 0); PG8_LDB(B1, 1, 1); PG8_SCHED; PG8_LDA(At, 1, 0); PG8_STAGE(PG8_SA(0, 1), a2 + hstepA, voffA);
            PG8_WAIT_V(8); PG8_WAIT_L(0); PG8_BAR; PG8_MMA(0, 0, At, B0); PG8_MMA(0, 1, At, B1); PG8_BAR; PG8_SCHED;
            PG8_LDA(At, 1, 1); PG8_STAGE(PG8_SB(1, 0), b3, voffB); PG8_STAGE(PG8_SB(1, 1), b3 + hstepB, voffB); PG8_STAGE(PG8_SA(1, 0), a3, voffA);
            PG8_WAIT_V(8); PG8_WAIT_L(0); PG8_BAR; PG8_MMA(1, 0, At, B0); PG8_MMA(1, 1, At, B1); PG8_BAR; PG8_SCHED;
        }
        if (wr == 0) PG8_BAR;
        const bool keep = E(acc, cur, wr, wc, fr, fq);
        if (!has_next) break;
        if (!keep) PG8_ZERO();
        cur = nxt; cA = nA; cB = nB; ++ui;
        if (wr == 1) PG8_BAR;
    }
    PG8_WAIT_V(0);
    PG8_BAR;
#undef PG8_SA
#undef PG8_SB
#undef PG8_STAGE
#undef PG8_LDA
#undef PG8_LDB
#undef PG8_MMA
#undef PG8_WAIT_V
#undef PG8_WAIT_L
#undef PG8_BAR
#undef PG8_SCHED
#undef PG8_ZERO
}
}

typedef __attribute__((address_space(1))) unsigned gu32;
#define XB_TMO      128
#define XB_XCNT(j)  (256  + 64 * (j))
#define XB_XSUB(j)  (1280 + 64 * (j))
#define XB_XGEN(j)  (2304 + 64 * (j))
#define XB_TOP      3328
#define XB_TOPGEN   3392
#define XCD_BAR_WORDS 3456
#define XB_SPIN_CAP (1u << 18)
__device__ __forceinline__ unsigned xb_ld(unsigned* p)              { return __hip_atomic_load(p, __ATOMIC_RELAXED, __HIP_MEMORY_SCOPE_AGENT); }
__device__ __forceinline__ unsigned xb_add(unsigned* p, unsigned v) { return __hip_atomic_fetch_add(p, v, __ATOMIC_RELAXED, __HIP_MEMORY_SCOPE_AGENT); }
__device__ __forceinline__ unsigned xb_xcc_id() { return (unsigned)__builtin_amdgcn_s_getreg((3 << 11) | 20) & 0xFu; }
#define XB_SPIN(cond, bar) do { unsigned _sp = 0; while (cond) { __builtin_amdgcn_s_sleep(1); \
    if ((++_sp & 255u) == 0u) { if (xb_ld(&(bar)[XB_TMO])) break; if (_sp > XB_SPIN_CAP) { atomicAdd(&(bar)[XB_TMO], 1u); break; } } } } while (0)
struct XcdBarrier { unsigned* bar; unsigned x; volatile LAS unsigned* st; };
__device__ __forceinline__ XcdBarrier xcd_barrier_post(unsigned* bar, volatile LAS unsigned* st) {
    XcdBarrier b; b.bar = bar; b.x = xb_xcc_id(); b.st = st;
    if (threadIdx.x == 0) (void)xb_add(&bar[XB_XCNT(b.x)], 1u);
    return b;
}
__device__ __forceinline__ void xcd_barrier_complete(unsigned* bar, unsigned x, unsigned& nloc, unsigned& nx) {
    const unsigned G = gridDim.x * gridDim.y * gridDim.z;
    unsigned sum, cnt, mine, sp = 0u;
    for (;;) {
        sum = 0u; cnt = 0u; mine = 0u;
#pragma unroll
        for (unsigned j = 0; j < 16; ++j) { const unsigned c = xb_ld(&bar[XB_XCNT(j)]); sum += c; cnt += (c > 0u) ? 1u : 0u; mine = (j == x) ? c : mine; }
        if (sum == G) break;
        __builtin_amdgcn_s_sleep(1);
        if ((++sp & 255u) == 0u) { if (xb_ld(&bar[XB_TMO])) break; if (sp > XB_SPIN_CAP) { atomicAdd(&bar[XB_TMO], 1u); break; } }
    }
    nloc = mine > 0u ? mine : 1u; nx = cnt > 0u ? cnt : 1u;
}
__device__ __forceinline__ void xcd_barrier(const XcdBarrier& b) {
    asm volatile("s_waitcnt vmcnt(0)" ::: "memory");
    __syncthreads();
    if (threadIdx.x == 0) {
        unsigned* bar = b.bar;
        __builtin_amdgcn_s_waitcnt(0);
        unsigned nloc = b.st[0], nx = b.st[1];
        if (nloc == 0u) { xcd_barrier_complete(bar, b.x, nloc, nx); b.st[0] = nloc; b.st[1] = nx; }
        const unsigned old = xb_add(&bar[XB_XSUB(b.x)], 1u);
        const unsigned gen = old / nloc;
        if (old + 1u == (gen + 1u) * nloc) {
            __builtin_amdgcn_fence(__ATOMIC_RELEASE, "agent");
            asm volatile("s_waitcnt vmcnt(0)" ::: "memory");
            const unsigned og = xb_add(&bar[XB_TOP], 1u);
            const unsigned tg = og / nx;
            if (og + 1u == (tg + 1u) * nx) xb_add(&bar[XB_TOPGEN], 1u);
            else XB_SPIN(xb_ld(&bar[XB_TOPGEN]) == tg, bar);
            __builtin_amdgcn_fence(__ATOMIC_ACQUIRE, "agent");
            xb_add(&bar[XB_XGEN(b.x)], 1u);
            asm volatile("s_waitcnt vmcnt(0)" ::: "memory");
        } else {
            XB_SPIN(xb_ld(&bar[XB_XGEN(b.x)]) == gen, bar);
            __builtin_amdgcn_fence(__ATOMIC_ACQUIRE, "agent");
            asm volatile("s_waitcnt vmcnt(0)" ::: "memory");
        }
    }
    __syncthreads();
}
__device__ __forceinline__ void rmsnorm_rows_h16(const float* __restrict__ src, const float* __restrict__ g, h16* dst) {
    int tid_ = threadIdx.x; asm volatile("" : "+v"(tid_));
    const int lane = tid_ & 63, wv = tid_ >> 6, nwv = blockDim.x >> 6;
    f32x4 gg[4];
#pragma unroll
    for (int j = 0; j < 4; ++j) gg[j] = ((const f32x4*)g)[lane + 64 * j];
    for (int r = 2 * (blockIdx.x * nwv + wv); r < M; r += 2 * gridDim.x * nwv) {
        f32x4 v[2][4]; float s[2] = {0.f, 0.f};
#pragma unroll
        for (int q = 0; q < 2; ++q)
#pragma unroll
            for (int j = 0; j < 4; ++j) v[q][j] = __builtin_nontemporal_load((const f32x4*)(src + (size_t)(r + q) * DM) + lane + 64 * j);
#pragma unroll
        for (int q = 0; q < 2; ++q) {
#pragma unroll
            for (int j = 0; j < 4; ++j) s[q] += (v[q][j][0] * v[q][j][0] + v[q][j][1] * v[q][j][1]) + (v[q][j][2] * v[q][j][2] + v[q][j][3] * v[q][j][3]);
            const float rs = rsqrtf(wave_sum(s[q]) * (1.f / DM) + EPS);
#pragma unroll
            for (int j = 0; j < 4; ++j) { const f32x4 o = v[q][j] * rs * gg[j]; uint2 w; w.x = pk2h(o[0], o[1]); w.y = pk2h(o[2], o[3]); *(uint2*)(dst + (size_t)(r + q) * DM + (lane + 64 * j) * 4) = w; }
        }
    }
}

__device__ __forceinline__ unsigned wave_suffix_sum(unsigned v, int lane) {
#pragma unroll
    for (int o = 1; o < 64; o <<= 1) { const unsigned t = __shfl_down(v, o); if (lane + o < 64) v += t; }
    return v;
}

typedef short s16x2 __attribute__((ext_vector_type(2)));
__device__ __forceinline__ unsigned okey2(unsigned x) { const s16x2 sg = __builtin_bit_cast(s16x2, x) >> (short)15; return x ^ (__builtin_bit_cast(unsigned, sg) | 0x80008000u); }
__device__ __forceinline__ unsigned wave_incl_scan(unsigned v, int lane) {
    (void)lane;
    int x = (int)v;
    x += __builtin_amdgcn_update_dpp(0, x, 0x111, 0xf, 0xf, false);
    x += __builtin_amdgcn_update_dpp(0, x, 0x112, 0xf, 0xf, false);
    x += __builtin_amdgcn_update_dpp(0, x, 0x114, 0xf, 0xf, false);
    x += __builtin_amdgcn_update_dpp(0, x, 0x118, 0xf, 0xf, false);
    x += __builtin_amdgcn_update_dpp(0, x, 0x142, 0xa, 0xf, false);
    x += __builtin_amdgcn_update_dpp(0, x, 0x143, 0xc, 0xf, false);
    return (unsigned)x;
}
__device__ __forceinline__ void hist_find4(const LAS unsigned* hist, int lane, unsigned k, unsigned& bucket, unsigned& need, unsigned& bcnt) {
    u32x4 h = *(const LAS u32x4*)(hist + 4 * lane);
#pragma unroll
    for (int c = 1; c < 4; ++c) h += *(const LAS u32x4*)(hist + c * 256 + 4 * lane);
    const unsigned s = h[0] + h[1] + h[2] + h[3];
    const unsigned pin = wave_incl_scan(s, lane);
    const unsigned S = (unsigned)__builtin_amdgcn_readlane((int)pin, 63) - pin + s;
    const unsigned above = S - s;
    const bool mine = (above < k) && (S >= k);
    unsigned bk = 0, nd = 0, bc = 0;
    if (mine) {
        unsigned cum = above;
        if (cum + h[3] >= k) { bk = 4 * lane + 3; nd = k - cum; bc = h[3]; }
        else { cum += h[3]; if (cum + h[2] >= k) { bk = 4 * lane + 2; nd = k - cum; bc = h[2]; }
        else { cum += h[2]; if (cum + h[1] >= k) { bk = 4 * lane + 1; nd = k - cum; bc = h[1]; }
        else { cum += h[1]; bk = 4 * lane; nd = k - cum; bc = h[0]; } } }
    }
    const unsigned long long mk = __ballot(mine);
    const int src = mk ? (int)__builtin_ctzll(mk) : 0;
    bucket = (unsigned)__builtin_amdgcn_readlane((int)bk, src); need = (unsigned)__builtin_amdgcn_readlane((int)nd, src); bcnt = (unsigned)__builtin_amdgcn_readlane((int)bc, src);
}
__device__ __forceinline__ void select_phase2(const h16* __restrict__ SC, unsigned short* IDX, LAS unsigned char* lds) {
    int tid_ = threadIdx.x; asm volatile("" : "+v"(tid_));
    const int lane = tid_ & 63, wv = __builtin_amdgcn_readfirstlane(tid_ >> 6);
    constexpr unsigned SEL_CAP = 1024;
    LAS unsigned* hist = (LAS unsigned*)(lds + wv * 16384);
    LAS unsigned* cand = hist + 1024;
    LAS unsigned char* lowb = (LAS unsigned char*)(hist + 2048);
    LAS unsigned* hc = hist + (lane & 3) * 256;
    const int gw = blockIdx.x * 8 + wv, ngw = gridDim.x * 8;
    auto loadrow = [&](int row, u32x4 (&v)[8]) __attribute__((always_inline)) {
        const int b = row >> 13, pos = row & (SEQ - 1), c = pos >> 6, q = pos & 63, n = (c + 1) * CH;
        if (n <= TOPK) return;
        const u32x4* sp4 = (const u32x4*)(SC + ((size_t)b * SC_BATCH + (size_t)4096 * ((size_t)c * (c + 1) / 2)) + (size_t)q * n);
#pragma unroll
        for (int j = 0; j < 8; ++j) { if (j * 512 + lane * 8 < n) v[j] = __builtin_nontemporal_load(sp4 + j * 64 + lane); else v[j] = (u32x4){0u, 0u, 0u, 0u}; }
    };
    auto process = [&](int row, u32x4 (&vp)[8]) __attribute__((always_inline)) {
        const int b = row >> 13, pos = row & (SEQ - 1), c = pos >> 6, q = pos & 63, n = (c + 1) * CH;
        unsigned short* out = IDX + (size_t)row * TOPK;
        if (n <= TOPK) { for (int j = lane; j < TOPK; j += 64) out[j] = j < n ? (unsigned short)j : (unsigned short)0xFFFF; return; }
        const u32x4* sp4 = (const u32x4*)(SC + ((size_t)b * SC_BATCH + (size_t)4096 * ((size_t)c * (c + 1) / 2)) + (size_t)q * n);
        u32x4 v[16];
#pragma unroll
        for (int j = 8; j < 16; ++j) { if (j * 512 + lane * 8 < n) v[j] = __builtin_nontemporal_load(sp4 + j * 64 + lane); else v[j] = (u32x4){0u, 0u, 0u, 0u}; }
#pragma unroll
        for (int j = 0; j < 8; ++j) v[j] = vp[j];
#pragma unroll
        for (int j = 0; j < 16; ++j) if (j * 512 < n) { typedef unsigned u32x2_ __attribute__((ext_vector_type(2)));
            const u32x2_ lb = (u32x2_){__builtin_amdgcn_perm(v[j].y, v[j].x, 0x06040200u), __builtin_amdgcn_perm(v[j].w, v[j].z, 0x06040200u)};
            *(LAS u32x2_*)(lowb + j * 512 + lane * 8) = lb; }
#pragma unroll
        for (int i = 0; i < 4; ++i) *(LAS u32x4*)(hist + i * 256 + 4 * lane) = (u32x4){0u, 0u, 0u, 0u};
        asm volatile("s_waitcnt lgkmcnt(0)" ::: "memory");
#pragma unroll
        for (int j = 0; j < 16; ++j) if (j * 512 < n) { if (j * 512 + lane * 8 < n) {
#pragma unroll
            for (int e = 0; e < 4; ++e) { const unsigned kw = v[j][e];
                __hip_atomic_fetch_add(hc + ((kw >> 8) & 255u), 1u, __ATOMIC_RELAXED, __HIP_MEMORY_SCOPE_WORKGROUP); __hip_atomic_fetch_add(hc + (kw >> 24), 1u, __ATOMIC_RELAXED, __HIP_MEMORY_SCOPE_WORKGROUP); } } }
        asm volatile("s_waitcnt lgkmcnt(0)" ::: "memory");
        unsigned b1, k1, c1; hist_find4(hist, lane, TOPK, b1, k1, c1);
        asm volatile("s_waitcnt lgkmcnt(0)" ::: "memory");
        if (c1 <= SEL_CAP) {
            unsigned md[4] = {0u, 0u, 0u, 0u}, mc[4] = {0u, 0u, 0u, 0u};
#pragma unroll
            for (int j = 0; j < 16; ++j) if (j * 512 < n) {
                unsigned d8 = 0, c8 = 0;
#pragma unroll
                for (int e = 0; e < 4; ++e) { const unsigned kw = v[j][e], hlo = (kw >> 8) & 255u, hhi = kw >> 24;
                    d8 |= (hlo > b1 ? 1u : 0u) << (2 * e); d8 |= (hhi > b1 ? 1u : 0u) << (2 * e + 1);
                    c8 |= (hlo == b1 ? 1u : 0u) << (2 * e); c8 |= (hhi == b1 ? 1u : 0u) << (2 * e + 1); }
                md[j >> 2] |= d8 << (8 * (j & 3)); mc[j >> 2] |= c8 << (8 * (j & 3));
            }
            const unsigned nd = (unsigned)(__popc(md[0]) + __popc(md[1]) + __popc(md[2]) + __popc(md[3]));
            const unsigned nc = (unsigned)(__popc(mc[0]) + __popc(mc[1]) + __popc(mc[2]) + __popc(mc[3]));
            unsigned based = wave_incl_scan(nd, lane) - nd, basec = wave_incl_scan(nc, lane) - nc;
#pragma unroll
            for (int w = 0; w < 4; ++w) {
                unsigned m = md[w];
                while (m) { const unsigned bt = (unsigned)__builtin_ctz(m); m &= m - 1u; const unsigned idx = (unsigned)((4 * w + (bt >> 3)) * 512 + lane * 8 + (bt & 7u)); if (based < TOPK) out[based] = (unsigned short)idx; ++based; }
                m = mc[w];
                while (m) { const unsigned bt = (unsigned)__builtin_ctz(m); m &= m - 1u; const unsigned idx = (unsigned)((4 * w + (bt >> 3)) * 512 + lane * 8 + (bt & 7u)); if (basec < SEL_CAP) cand[basec] = idx; ++basec; }
            }
            asm volatile("s_waitcnt lgkmcnt(0)" ::: "memory");
#pragma unroll
            for (int i = 0; i < 4; ++i) *(LAS u32x4*)(hist + i * 256 + 4 * lane) = (u32x4){0u, 0u, 0u, 0u};
            asm volatile("s_waitcnt lgkmcnt(0)" ::: "memory");
            for (unsigned i = lane; i < c1; i += 64) { const unsigned idx = cand[i]; const unsigned kk = (unsigned)lowb[idx]; cand[i] = (kk << 16) | idx;
                __hip_atomic_fetch_add(hist + kk, 1u, __ATOMIC_RELAXED, __HIP_MEMORY_SCOPE_WORKGROUP); }
            asm volatile("s_waitcnt lgkmcnt(0)" ::: "memory");
            unsigned b2, k2, tt; hist_find4(hist, lane, k1, b2, k2, tt);
            asm volatile("s_waitcnt lgkmcnt(0)" ::: "memory");
            unsigned ob = TOPK - k1, tcount = 0;
            LAS unsigned* tl = hist;
            for (unsigned i0 = 0; i0 < c1; i0 += 64) {
                const unsigned i = i0 + lane; const bool inr = i < c1;
                const unsigned cv = inr ? cand[i] : 0u, lo = cv >> 16, idx = cv & 0xFFFFu;
                const bool take = inr && lo > b2, tie = inr && lo == b2;
                const unsigned long long mt = __ballot(take), mq = __ballot(tie), ltm = (1ull << lane) - 1ull;
                const unsigned ps = ob + (unsigned)__popcll(mt & ltm);
                if (take && ps < TOPK) out[ps] = (unsigned short)idx;
                if (tie) tl[tcount + (unsigned)__popcll(mq & ltm)] = idx;
                ob += (unsigned)__popcll(mt); tcount += (unsigned)__popcll(mq);
            }
            asm volatile("s_waitcnt lgkmcnt(0)" ::: "memory");
            if (tt == k2) { for (unsigned i = lane; i < tt; i += 64) { const unsigned ps = ob + i; if (ps < TOPK) out[ps] = (unsigned short)tl[i]; } }
            else {
                for (unsigned i0 = 0; i0 < tt; i0 += 64) {
                    const unsigned i = i0 + lane; const bool inr = i < tt; const unsigned my = inr ? tl[i] : 0xFFFFFFFFu;
                    unsigned rk = 0; for (unsigned q2 = 0; q2 < tt; ++q2) rk += tl[q2] < my ? 1u : 0u;
                    if (inr && rk < k2 && ob + rk < TOPK) out[ob + rk] = (unsigned short)my;
                }
            }
            asm volatile("s_waitcnt lgkmcnt(0)" ::: "memory");
        } else {
#pragma unroll
        for (int i = 0; i < 4; ++i) *(LAS u32x4*)(hist + i * 256 + 4 * lane) = (u32x4){0u, 0u, 0u, 0u};
        asm volatile("s_waitcnt lgkmcnt(0)" ::: "memory");
#pragma unroll
        for (int j = 0; j < 16; ++j) if (j * 512 < n) {
#pragma unroll
            for (int e = 0; e < 4; ++e) { const unsigned kw = v[j][e];
                if (((kw >> 8) & 255u) == b1) __hip_atomic_fetch_add(hc + (kw & 255u), 1u, __ATOMIC_RELAXED, __HIP_MEMORY_SCOPE_WORKGROUP);
                if ((kw >> 24) == b1) __hip_atomic_fetch_add(hc + ((kw >> 16) & 255u), 1u, __ATOMIC_RELAXED, __HIP_MEMORY_SCOPE_WORKGROUP); } }
        asm volatile("s_waitcnt lgkmcnt(0)" ::: "memory");
        unsigned b2, k2, tt; hist_find4(hist, lane, k1, b2, k2, tt);
        asm volatile("s_waitcnt lgkmcnt(0)" ::: "memory");
        const unsigned T = (b1 << 8) | b2;
        const bool all_ties = (tt == k2);
        if (all_ties) {
            unsigned msk[4] = {0u, 0u, 0u, 0u};
#pragma unroll
            for (int j = 0; j < 16; ++j) if (j * 512 < n) {
                unsigned tk = 0;
#pragma unroll
                for (int e = 0; e < 4; ++e) { const unsigned kw = v[j][e]; tk |= ((kw & 0xFFFFu) >= T ? 1u : 0u) << (2 * e); tk |= ((kw >> 16) >= T ? 1u : 0u) << (2 * e + 1); }
                msk[j >> 2] |= tk << (8 * (j & 3));
            }
            const unsigned cn = (unsigned)(__popc(msk[0]) + __popc(msk[1]) + __popc(msk[2]) + __popc(msk[3]));
            unsigned base = wave_incl_scan(cn, lane) - cn;
#pragma unroll
            for (int j = 0; j < 16; ++j) if (j * 512 < n) {
                const unsigned tk = (msk[j >> 2] >> (8 * (j & 3))) & 255u;
                if (__ballot(tk != 0u)) {
#pragma unroll
                    for (int e = 0; e < 8; ++e) if ((tk >> e) & 1u) { if (base < TOPK) out[base] = (unsigned short)(j * 512 + lane * 8 + e); ++base; }
                }
            }
        } else {
        unsigned run = 0, trun = 0;
#pragma unroll
        for (int j = 0; j < 16; ++j) if (j * 512 < n) {
            unsigned tk = 0, tm = 0;
#pragma unroll
            for (int e = 0; e < 4; ++e) { const unsigned kw = v[j][e], klo = kw & 0xFFFFu, khi = kw >> 16;
                tk |= (klo > T ? 1u : 0u) << (2 * e); tk |= (khi > T ? 1u : 0u) << (2 * e + 1);
                tm |= (klo == T ? 1u : 0u) << (2 * e); tm |= (khi == T ? 1u : 0u) << (2 * e + 1); }
            {
                const unsigned tc = (unsigned)__popc(tm);
                const unsigned tin = wave_incl_scan(tc, lane);
                const unsigned tbase = trun + tin - tc;
#pragma unroll
                for (int e = 0; e < 8; ++e) if (((tm >> e) & 1u) && (tbase + (unsigned)__popc(tm & ((1u << e) - 1u))) < k2) tk |= 1u << e;
                trun += (unsigned)__shfl(tin, 63);
            }
            const unsigned cn = (unsigned)__popc(tk);
            const unsigned inc = wave_incl_scan(cn, lane);
            unsigned base = run + inc - cn;
#pragma unroll
            for (int e = 0; e < 8; ++e) if ((tk >> e) & 1u) { if (base < TOPK) out[base] = (unsigned short)(j * 512 + lane * 8 + e); ++base; }
            run += (unsigned)__shfl(inc, 63);
        }
        }
        }
    };
    auto rowof = [&](int i) __attribute__((always_inline)) -> int {
        if (ngw != 2048) { const long r = (long)gw + (long)i * ngw; return r < M ? (int)r : -1; }
        if (i >= 8) return -1;
        const int j = i & 3, pos = j == 0 ? gw : (j == 1 ? 4095 - gw : (j == 2 ? 4096 + gw : 8191 - gw));
        return (i >> 2) * SEQ + pos;
    };
    u32x4 vA[8], vB[8];
    int it = 0, row = rowof(0);
    if (row >= 0) loadrow(row, vA);
    while (row >= 0) {
        const int r1 = rowof(it + 1), r2 = rowof(it + 2);
        if (r1 >= 0) loadrow(r1, vB);
        process(row, vA);
        if (r2 >= 0) loadrow(r2, vA);
        if (r1 >= 0) process(r1, vB);
        row = r2; it += 2;
    }
}

typedef float f32x16 __attribute__((ext_vector_type(16)));
__device__ __forceinline__ void scores_phase(const h16* __restrict__ QI, const h16* __restrict__ KI, const float* __restrict__ WI, h16* SC, LAS unsigned char* lds) {
    int tid_ = threadIdx.x; asm volatile("" : "+v"(tid_));
    const int tid = tid_, lane = tid & 63, wv = __builtin_amdgcn_readfirstlane(tid >> 6), r32 = lane & 31, hi = lane >> 5;
    for (int bx = blockIdx.x; bx < 256; bx += gridDim.x) {
    const int b = bx >> 7, jj = (bx >> 1) & 63, par = bx & 1;
    const int rho_s = tid >> 3, cp_s = tid & 7;
    const int skey = 2 * (rho_s & 31) + (rho_s >> 5), schunk = cp_s ^ ((rho_s >> 1) & 7);
    const h16* ksrc0 = KI + ((size_t)b * SEQ + skey) * IDIM + schunk * 8;
    for (int uu = 0; uu < 2; ++uu) {
        const int c = uu == 0 ? jj : (NCH - 1 - jj);
        const int n = (c + 1) * CH;
        const int nmy = (c + 1 - par + 1) >> 1;
        const size_t row0 = (size_t)b * SEQ + (size_t)c * CH + wv * 8;
        h16x8 A[4][4]; h16x8 w[4][2];
#pragma unroll
        for (int pr = 0; pr < 4; ++pr) {
            const h16* ap = QI + (row0 + 2 * pr + ((r32 >> 2) & 1)) * DM + ((r32 & 3) + 4 * (r32 >> 3)) * IDIM + 8 * hi;
#pragma unroll
            for (int ks = 0; ks < 4; ++ks) A[pr][ks] = *(const h16x8*)(ap + 16 * ks);
            const float* wp = WI + (row0 + 2 * pr + hi) * IH;
#pragma unroll
            for (int i = 0; i < 2; ++i) { const f32x4 t4 = *(const f32x4*)(wp + 8 * i), t5 = *(const f32x4*)(wp + 8 * i + 4); w[pr][i] = __builtin_bit_cast(h16x8, pack8(t4, t5)); }
        }
        h16* scq = SC + ((size_t)b * SC_BATCH + (size_t)4096 * ((size_t)c * (c + 1) / 2)) + (size_t)(wv * 8 + hi) * n + 2 * r32;
        asm volatile("s_waitcnt vmcnt(0)" ::: "memory");
#pragma unroll
        for (int pr = 0; pr < 4; ++pr) asm volatile("" : "+v"(A[pr][0]), "+v"(A[pr][1]), "+v"(A[pr][2]), "+v"(A[pr][3]), "+v"(w[pr][0]), "+v"(w[pr][1]));
        __syncthreads();
        if (nmy > 0) __builtin_amdgcn_global_load_lds((const unsigned*)(ksrc0 + (size_t)par * CH * IDIM), (LAS unsigned*)(lds + wv * 1024), 16, 0, 0);
        if (nmy > 1) __builtin_amdgcn_global_load_lds((const unsigned*)(ksrc0 + (size_t)(par + 2) * CH * IDIM), (LAS unsigned*)(lds + 8192 + wv * 1024), 16, 0, 0);
        for (int i = 0; i < nmy; ++i) {
            const int t = par + 2 * i;
            if (i == 0) { if (nmy > 1) asm volatile("s_waitcnt vmcnt(1)" ::: "memory"); else asm volatile("s_waitcnt vmcnt(0)" ::: "memory"); }
            else if (i == 1) { if (i + 1 < nmy) asm volatile("s_waitcnt vmcnt(5)" ::: "memory"); else asm volatile("s_waitcnt vmcnt(4)" ::: "memory"); }
            else if (i + 1 < nmy) asm volatile("s_waitcnt vmcnt(9)" ::: "memory"); else asm volatile("s_waitcnt vmcnt(8)" ::: "memory");
            __builtin_amdgcn_s_barrier();
            if (i + 2 < nmy) __builtin_amdgcn_global_load_lds((const unsigned*)(ksrc0 + (size_t)(t + 4) * CH * IDIM), (LAS unsigned*)(lds + ((i + 2) % 3) * 8192 + wv * 1024), 16, 0, 0);
            const LAS unsigned char* buf = lds + (i % 3) * 8192;
            float sc[2][4];
#pragma unroll
            for (int f = 0; f < 2; ++f) {
                const int rho = f * 32 + r32;
                h16x8 B[4];
#pragma unroll
                for (int ks = 0; ks < 4; ++ks) B[ks] = *(const LAS h16x8*)(buf + rho * 128 + (((ks * 2 + hi) ^ ((rho >> 1) & 7)) << 4));
#pragma unroll
                for (int pr = 0; pr < 4; ++pr) {
                    f32x16 acc;
#pragma unroll
                    for (int e = 0; e < 16; ++e) acc[e] = 0.f;
                    __builtin_amdgcn_s_setprio(1);
#pragma unroll
                    for (int ks = 0; ks < 4; ++ks) acc = __builtin_amdgcn_mfma_f32_32x32x16_f16(A[pr][ks], B[ks], acc, 0, 0, 0);
                    __builtin_amdgcn_s_setprio(0);
                    float s = 0.f;
#pragma unroll
                    for (int e = 0; e < 16; ++e) { const float xe = acc[e]; int ib = __float_as_int(xe); ib = ib > 0 ? ib : 0;
                        s = __builtin_fmaf(__int_as_float(ib), (float)w[pr][e >> 3][e & 7], s); }
                    sc[f][pr] = s;
                }
            }
#pragma unroll
            for (int pr = 0; pr < 4; ++pr) __builtin_nontemporal_store(okey2(pk2h(sc[0][pr], sc[1][pr])), (unsigned*)(scq + (size_t)(2 * pr) * n + t * CH));
        }
    }
    }
    asm volatile("s_waitcnt vmcnt(0)" ::: "memory");
    __syncthreads();
}

typedef _Float16 h16x4 __attribute__((ext_vector_type(4)));
__device__ __forceinline__ void tr8(h16x4 (&r)[8], unsigned a0, unsigned a1, unsigned a2, unsigned a3, unsigned a4, unsigned a5, unsigned a6, unsigned a7) {
    asm volatile("ds_read_b64_tr_b16 %0, %8\n\tds_read_b64_tr_b16 %1, %9\n\tds_read_b64_tr_b16 %2, %10\n\tds_read_b64_tr_b16 %3, %11\n\t"
                 "ds_read_b64_tr_b16 %4, %12\n\tds_read_b64_tr_b16 %5, %13\n\tds_read_b64_tr_b16 %6, %14\n\tds_read_b64_tr_b16 %7, %15\n\ts_waitcnt lgkmcnt(0)"
                 : "=&v"(r[0]), "=&v"(r[1]), "=&v"(r[2]), "=&v"(r[3]), "=&v"(r[4]), "=&v"(r[5]), "=&v"(r[6]), "=&v"(r[7])
                 : "v"(a0), "v"(a1), "v"(a2), "v"(a3), "v"(a4), "v"(a5), "v"(a6), "v"(a7) : "memory");
}
__device__ __forceinline__ void tr8b(long (&r)[8], unsigned a0, unsigned a1, unsigned a2, unsigned a3, unsigned a4, unsigned a5, unsigned a6, unsigned a7) {
    asm volatile("ds_read_b64_tr_b8 %0, %8\n\tds_read_b64_tr_b8 %1, %9\n\tds_read_b64_tr_b8 %2, %10\n\tds_read_b64_tr_b8 %3, %11\n\t"
                 "ds_read_b64_tr_b8 %4, %12\n\tds_read_b64_tr_b8 %5, %13\n\tds_read_b64_tr_b8 %6, %14\n\tds_read_b64_tr_b8 %7, %15\n\ts_waitcnt lgkmcnt(0)"
                 : "=&v"(r[0]), "=&v"(r[1]), "=&v"(r[2]), "=&v"(r[3]), "=&v"(r[4]), "=&v"(r[5]), "=&v"(r[6]), "=&v"(r[7])
                 : "v"(a0), "v"(a1), "v"(a2), "v"(a3), "v"(a4), "v"(a5), "v"(a6), "v"(a7) : "memory");
}
__device__ __forceinline__ void attn_phase(const h16* __restrict__ Q, const h16* __restrict__ K, const h16* __restrict__ V, const unsigned short* __restrict__ IDX, h16* YB, LAS unsigned char* lds) {
    int tid_ = threadIdx.x; asm volatile("" : "+v"(tid_));
    const int lane = tid_ & 63, wv = __builtin_amdgcn_readfirstlane(tid_ >> 6), c16 = lane & 15, gg = lane >> 4;
    LAS unsigned char* wl = lds + wv * 17408;
    LAS unsigned short* ktab = (LAS unsigned short*)(wl + 16384);
    LAS unsigned short* vtab = ktab + 256;
    const int tabK = (((lane >> 3) * 8 + 4 * (lane & 1)) * 4 + ((lane >> 1) & 3)), tabV = (((lane >> 3) * 8 + 4 * ((lane >> 2) & 1)) * 4 + (lane & 3));
    const unsigned trbase8 = (unsigned)(size_t)wl + (unsigned)((8 * gg + (c16 >> 1)) * 128 + 8 * (c16 & 1));
    const unsigned trx8 = (unsigned)(((4 * (gg & 1) + (c16 >> 2)) & 7) << 4);
    const int bx = blockIdx.x, xl = bx & 7, ci = bx >> 3;
    const int gfix = (xl >> 1) & 1;
    const unsigned loffA = (unsigned)(gfix * 128 + 16 * ((lane & 7) ^ (lane >> 4))), loffB = (unsigned)(gfix * 128 + 16 * ((lane & 7) ^ (4 + (lane >> 4))));
    const float SCL = 0.08838834764831845f * 1.4426950408889634f;
    const int rowbase = (xl >> 2) * SEQ + (xl & 1) * 4096 + ci * 128 + wv * 16;
    unsigned long long idr = 0ull; h16x8 qr[4];
    if (ci < 32) { idr = *(const unsigned long long*)(IDX + (size_t)rowbase * TOPK + lane * 4);
        const h16* qp = Q + (size_t)rowbase * DM + (4 * gfix + (lane & 3)) * HD + 8 * gg;
#pragma unroll
        for (int ks = 0; ks < 4; ++ks) qr[ks] = *(const h16x8*)(qp + 32 * ks); }
    for (int qi = 0; qi < 16; ++qi) {
        const int row = rowbase + qi;
        if (ci >= 32) break;
        const int b = row >> 13, pos = row & (SEQ - 1);
        const int nadm = ((pos >> 6) + 1) * CH, nvalid = nadm < TOPK ? nadm : TOPK;
        asm volatile("s_waitcnt lgkmcnt(0)" ::: "memory");
#pragma unroll
        for (int e = 0; e < 4; ++e) { unsigned idv = (unsigned)(idr >> (16 * e)) & 0xFFFFu; idv = idv == 0xFFFFu ? 0u : idv;
            ktab[tabK + 4 * e] = (unsigned short)idv; vtab[tabV + 4 * e] = (unsigned short)idv; }
        const unsigned char* K8b = (const unsigned char*)K + (size_t)b * SEQ * 256; const unsigned char* V8b = (const unsigned char*)V + (size_t)b * SEQ * 256;
        { const int g = gfix;
            long Bq[4];
#pragma unroll
            for (int ks = 0; ks < 4; ++ks) { const h16x8 qv = qr[ks]; int lo = 0, hi2 = 0;
                lo = __builtin_amdgcn_cvt_pk_fp8_f32((float)qv[0], (float)qv[1], lo, false); lo = __builtin_amdgcn_cvt_pk_fp8_f32((float)qv[2], (float)qv[3], lo, true);
                hi2 = __builtin_amdgcn_cvt_pk_fp8_f32((float)qv[4], (float)qv[5], hi2, false); hi2 = __builtin_amdgcn_cvt_pk_fp8_f32((float)qv[6], (float)qv[7], hi2, true);
                Bq[ks] = (long)(((unsigned long long)(unsigned)hi2 << 32) | (unsigned long long)(unsigned)lo); }
            asm volatile("s_waitcnt lgkmcnt(0)" : "+v"(Bq[0]), "+v"(Bq[1]), "+v"(Bq[2]), "+v"(Bq[3]) :: "memory");
            if (qi + 1 < 16) { idr = *(const unsigned long long*)(IDX + (size_t)(row + 1) * TOPK + lane * 4);
                const h16* qp = Q + (size_t)(row + 1) * DM + (4 * g + (lane & 3)) * HD + 8 * gg;
#pragma unroll
                for (int ks = 0; ks < 4; ++ks) qr[ks] = *(const h16x8*)(qp + 32 * ks); }
#define ATT_TAB(cc_) (*(const LAS unsigned long long*)(((cc_) < 8 ? ktab : vtab) + ((((cc_) & 7) * 8 + (lane >> 3)) * 4)))
#define ATT_DMA(cc_, w4_) do { const unsigned char* base_ = (cc_) < 8 ? K8b : V8b; _Pragma("unroll") for (int i_ = 0; i_ < 4; ++i_) { \
                const unsigned vo_ = (((unsigned)((w4_) >> (16 * i_)) & 0xFFFFu) << 8) + ((i_ & 1) ? loffB : loffA); \
                __builtin_amdgcn_global_load_lds((const unsigned*)(base_ + vo_), (LAS unsigned*)(wl + ((cc_) & 3) * 4096 + i_ * 1024), 16, 0, 0); } } while (0)
#define ATT_SZ(cc_) ((cc_) < 16 ? 4 : 0)
#define ATT_WAITN(n_) do { if ((n_) == 12) asm volatile("s_waitcnt vmcnt(12)" ::: "memory"); else if ((n_) == 10) asm volatile("s_waitcnt vmcnt(10)" ::: "memory"); else if ((n_) == 8) asm volatile("s_waitcnt vmcnt(8)" ::: "memory"); \
                else if ((n_) == 6) asm volatile("s_waitcnt vmcnt(6)" ::: "memory"); else if ((n_) == 4) asm volatile("s_waitcnt vmcnt(4)" ::: "memory"); else asm volatile("s_waitcnt vmcnt(0)" ::: "memory"); } while (0)
#define ATT_STEP_WAIT(c_) do { asm volatile("s_waitcnt lgkmcnt(0)" ::: "memory"); \
                if ((c_) + 3 < 16) { ATT_DMA((c_) + 3, idn); if ((c_) + 4 < 16) idn = ATT_TAB((c_) + 4); } \
                ATT_WAITN(ATT_SZ((c_) + 1) + ATT_SZ((c_) + 2) + ATT_SZ((c_) + 3)); } while (0)
            unsigned long long idn;
            { const unsigned long long w0 = ATT_TAB(0), w1 = ATT_TAB(1), w2 = ATT_TAB(2); idn = ATT_TAB(3); asm volatile("s_waitcnt lgkmcnt(0)" ::: "memory"); ATT_DMA(0, w0); ATT_DMA(1, w1); ATT_DMA(2, w2); }
            f32x4 S[16];
#pragma unroll
            for (int c = 0; c < 8; ++c) {
                ATT_STEP_WAIT(c);
#pragma unroll
                for (int h2 = 0; h2 < 2; ++h2) {
                    const LAS unsigned char* kb_ = wl + (c & 3) * 4096 + (16 * h2 + c16) * 128;
                    f32x4 acc = (f32x4){0.f, 0.f, 0.f, 0.f};
#pragma unroll
                    for (int ks = 0; ks < 4; ++ks) { const long a = *(const LAS long*)(kb_ + (((2 * ks + (gg >> 1)) ^ (c16 >> 1)) << 4) + (gg & 1) * 8); acc = __builtin_amdgcn_mfma_f32_16x16x32_fp8_fp8(a, Bq[ks], acc, 0, 0, 0); }
                    S[2 * c + h2] = acc;
                }
            }
            float mx = -1e30f;
            if (nvalid >= TOPK) {
#pragma unroll
                for (int t = 0; t < 16; ++t)
#pragma unroll
                    for (int r = 0; r < 4; ++r) mx = fmaxf(mx, S[t][r]);
            } else {
#pragma unroll
                for (int t = 0; t < 16; ++t)
#pragma unroll
                    for (int r = 0; r < 4; ++r) { const float s = (16 * t + 4 * gg + r) < nvalid ? S[t][r] : -1e30f; S[t][r] = s; mx = fmaxf(mx, s); }
            }
            mx = fmaxf(mx, __shfl_xor(mx, 16)); mx = fmaxf(mx, __shfl_xor(mx, 32));
            const float nb = 8.f - mx * SCL;
            float sum = 0.f;
#pragma unroll
            for (int t = 0; t < 16; ++t)
#pragma unroll
                for (int r = 0; r < 4; ++r) { const float pv = __builtin_amdgcn_exp2f(__builtin_fmaf(S[t][r], SCL, nb)); S[t][r] = pv; sum += pv; }
            sum += __shfl_xor(sum, 16); sum += __shfl_xor(sum, 32);
            long Pk[8];
#pragma unroll
            for (int s = 0; s < 8; ++s) { int lo = 0, hi2 = 0;
                lo = __builtin_amdgcn_cvt_pk_fp8_f32(S[2 * s][0], S[2 * s][1], lo, false); lo = __builtin_amdgcn_cvt_pk_fp8_f32(S[2 * s][2], S[2 * s][3], lo, true);
                hi2 = __builtin_amdgcn_cvt_pk_fp8_f32(S[2 * s + 1][0], S[2 * s + 1][1], hi2, false); hi2 = __builtin_amdgcn_cvt_pk_fp8_f32(S[2 * s + 1][2], S[2 * s + 1][3], hi2, true);
                Pk[s] = (long)(((unsigned long long)(unsigned)hi2 << 32) | (unsigned long long)(unsigned)lo); }
            f32x4 O[8];
#pragma unroll
            for (int mt = 0; mt < 8; ++mt) O[mt] = (f32x4){0.f, 0.f, 0.f, 0.f};
#pragma unroll
            for (int c = 8; c < 16; ++c) {
                ATT_STEP_WAIT(c);
                long av[8];
                { const unsigned rb = trbase8 + (c & 3) * 4096;
                  tr8b(av, rb + (trx8 ^ 0u), rb + (trx8 ^ 16u), rb + (trx8 ^ 32u), rb + (trx8 ^ 48u), rb + (trx8 ^ 64u), rb + (trx8 ^ 80u), rb + (trx8 ^ 96u), rb + (trx8 ^ 112u)); }
#pragma unroll
                for (int mt = 0; mt < 8; ++mt) O[mt] = __builtin_amdgcn_mfma_f32_16x16x32_fp8_fp8(av[mt], Pk[c - 8], O[mt], 0, 0, 0);
            }
#undef ATT_TAB
#undef ATT_DMA
#undef ATT_STEP_WAIT
#undef ATT_SZ
#undef ATT_WAITN
            const float inv = __builtin_amdgcn_rcpf(sum);
            if (c16 < 4) {
                h16* op = YB + (size_t)row * DM + (4 * g + c16) * HD + 4 * gg;
#pragma unroll
                for (int mt = 0; mt < 8; ++mt) { uint2 o2; o2.x = pk2h(O[mt][0] * inv, O[mt][1] * inv); o2.y = pk2h(O[mt][2] * inv, O[mt][3] * inv); *(uint2*)(op + 16 * mt) = o2; }
            }
        }
    }
    asm volatile("s_waitcnt vmcnt(0) lgkmcnt(0)" ::: "memory");
}

typedef f32x4 AccT[2][2][4][2];
#define EPI_ROWS(u) const int row0 = (u).pm * 256 + wr * 64 + fr, cw0 = wc * 32 + 8 * fq
#define EPI_FOR _Pragma("unroll") for (int ai = 0; ai < 2; ++ai) _Pragma("unroll") for (int m = 0; m < 4; ++m)

struct EpiInProj {
    h16 *U, *Q, *K, *V, *QI, *KI; float* WI;
    static __device__ __forceinline__ void rot8(f32x4& a, f32x4& b, const f32x4& pa, const f32x4& pb, float fpos, const float (&ifr)[8], float sgn) {
#pragma unroll
        for (int j = 0; j < 4; ++j) {
            const float r0 = __builtin_amdgcn_fractf(fpos * ifr[j]), r1 = __builtin_amdgcn_fractf(fpos * ifr[4 + j]);
            a[j] = a[j] * __builtin_amdgcn_cosf(r0) + pa[j] * (sgn * __builtin_amdgcn_sinf(r0));
            b[j] = b[j] * __builtin_amdgcn_cosf(r1) + pb[j] * (sgn * __builtin_amdgcn_sinf(r1));
        }
    }
    __device__ __forceinline__ bool operator()(AccT& acc, const pg8::Unit& u, int wr, int wc, int fr, int fq) const {
        EPI_ROWS(u); const int pn = u.pn;
        const bool ropeA = (pn >= 4 && pn <= 8) && wc == 0;
        const bool ropeI = (pn >= 10 && pn <= 13 && (wc & 1) == 0) || (pn == 14 && wc == 0);
        float ifr[8];
#pragma unroll
        for (int e = 0; e < 8; ++e) ifr[e] = 0.15915494309189535f * __builtin_amdgcn_exp2f(-18.931568569324174f * (ropeA ? (float)(8 * (fq & 1) + e) * (1.f / 16.f) : (float)e * (1.f / 8.f)));
        const float sgnA = fq < 2 ? -1.f : 1.f, sgnI = fq == 0 ? -1.f : (fq == 1 ? 1.f : 0.f);
        if (pn < 4) {
            EPI_FOR { const int row = row0 + ai * 128 + m * 16;
#pragma unroll
                for (int bj = 0; bj < 2; ++bj) { const int col = pn * 256 + cw0 + bj * 128;
                    *(u32x4*)(U + ((size_t)(col >> 4) * 512 + (size_t)(row >> 5)) * 640 + (row & 31) * 16 + (col & 15)) = pack8(acc[ai][bj][m][0], acc[ai][bj][m][1]); } }
        } else if (pn < 14) {
            h16* base; int ld;
            if (pn < 8) { base = Q + (pn - 4) * 256; ld = DM; }
            else if (pn == 8) { base = K; ld = KVW; } else if (pn == 9) { base = V; ld = KVW; } else { base = QI + (pn - 10) * 256; ld = DM; }
            EPI_FOR { const size_t row = (size_t)(row0 + ai * 128 + m * 16); const float fpos = (float)((int)row & (SEQ - 1));
#pragma unroll
                for (int bj = 0; bj < 2; ++bj) { f32x4 a = acc[ai][bj][m][0], b = acc[ai][bj][m][1];
                    if (ropeA || ropeI) { f32x4 pa, pb; const int xm = ropeA ? 32 : 16;
#pragma unroll
                        for (int j = 0; j < 4; ++j) { pa[j] = __shfl_xor(a[j], xm); pb[j] = __shfl_xor(b[j], xm); }
                        if (ropeA || fq < 2) rot8(a, b, pa, pb, fpos, ifr, ropeA ? sgnA : sgnI); }
                    if (pn == 8 || pn == 9) { uint2 w8; int lo = 0, hi2 = 0;
                        unsigned char* K = pn == 8 ? (unsigned char*)this->K : (unsigned char*)this->V;
                        lo = __builtin_amdgcn_cvt_pk_fp8_f32(a[0], a[1], lo, false); lo = __builtin_amdgcn_cvt_pk_fp8_f32(a[2], a[3], lo, true);
                        hi2 = __builtin_amdgcn_cvt_pk_fp8_f32(b[0], b[1], hi2, false); hi2 = __builtin_amdgcn_cvt_pk_fp8_f32(b[2], b[3], hi2, true);
                        w8.x = (unsigned)lo; w8.y = (unsigned)hi2; typedef unsigned u32x2n_ __attribute__((ext_vector_type(2))); __builtin_nontemporal_store((u32x2n_){w8.x, w8.y}, (u32x2n_*)((unsigned char*)K + row * 256 + cw0 + bj * 128)); }
                    else __builtin_nontemporal_store(pack8(a, b), (u32x4*)(base + row * ld + cw0 + bj * 128)); } }
        } else {
            EPI_FOR { const size_t row = (size_t)(row0 + ai * 128 + m * 16); const float fpos = (float)((int)row & (SEQ - 1));
                f32x4 a = acc[ai][0][m][0], b = acc[ai][0][m][1];
                if (ropeI) { f32x4 pa, pb;
#pragma unroll
                    for (int j = 0; j < 4; ++j) { pa[j] = __shfl_xor(a[j], 16); pb[j] = __shfl_xor(b[j], 16); }
                    if (fq < 2) rot8(a, b, pa, pb, fpos, ifr, sgnI); }
                if (cw0 < 64) __builtin_nontemporal_store(pack8(a, b), (u32x4*)(KI + row * IDIM + cw0));
                else if (cw0 < 80) { float* wp = WI + row * IH + (cw0 - 64); *(f32x4*)wp = a * (1.f / 32.f); *(f32x4*)(wp + 4) = b * (1.f / 32.f); } }
        }
        return false;
    }
};
struct EpiGlu {
    const h16* YS; h16* YA;
    __device__ __forceinline__ bool operator()(AccT& acc, const pg8::Unit& u, int wr, int wc, int fr, int fq) const {
        EPI_ROWS(u);
        h16x8 yv[2][4][2];
        EPI_FOR { const size_t row = (size_t)(row0 + ai * 128 + m * 16);
#pragma unroll
            for (int bj = 0; bj < 2; ++bj) yv[ai][m][bj] = *(const h16x8*)(YS + row * DM + u.pn * 256 + cw0 + bj * 128); }
        EPI_FOR { const size_t row = (size_t)(row0 + ai * 128 + m * 16);
#pragma unroll
            for (int bj = 0; bj < 2; ++bj) { const size_t o = row * DM + u.pn * 256 + cw0 + bj * 128; const h16x8 y = yv[ai][m][bj];
                f32x4 a = acc[ai][bj][m][0], b = acc[ai][bj][m][1];
#pragma unroll
                for (int j = 0; j < 4; ++j) { a[j] = (float)y[j] * sigmoidf_(a[j]); b[j] = (float)y[4 + j] * sigmoidf_(b[j]); }
                __builtin_nontemporal_store(pack8(a, b), (u32x4*)(YA + o)); } }
        return false;
    }
};
struct EpiMerge {
    h16 *SA, *SB, *MG;
    __device__ __forceinline__ bool operator()(AccT& acc, const pg8::Unit& u, int wr, int wc, int fr, int fq) const {
        EPI_ROWS(u); const int tag = u.tag;
        EPI_FOR { const size_t row = (size_t)(row0 + ai * 128 + m * 16);
#pragma unroll
            for (int bj = 0; bj < 2; ++bj) { const size_t o = row * DM + u.pn * 256 + cw0 + bj * 128;
                f32x4 a = acc[ai][bj][m][0], b = acc[ai][bj][m][1];
                if (tag < 2) {
#pragma unroll
                    for (int j = 0; j < 4; ++j) { a[j] = sigmoidf_(a[j]); b[j] = sigmoidf_(b[j]); }
                    *(u32x4*)((tag == 0 ? SA : SB) + o) = pack8(a, b);
                } else if (tag == 2) {
                    const h16x8 sa = *(const h16x8*)(SA + o), sb = *(const h16x8*)(SB + o);
#pragma unroll
                    for (int j = 0; j < 4; ++j) { a[j] *= (float)sa[j] * __builtin_amdgcn_rcpf((float)sb[j]); b[j] *= (float)sa[4 + j] * __builtin_amdgcn_rcpf((float)sb[4 + j]); }
                    acc[ai][bj][m][0] = a; acc[ai][bj][m][1] = b;
                } else {
                    const h16x8 sb = *(const h16x8*)(SB + o);
#pragma unroll
                    for (int j = 0; j < 4; ++j) { a[j] *= (float)sb[j]; b[j] *= (float)sb[4 + j]; }
                    *(u32x4*)(MG + o) = pack8(a, b);
                } }
            asm volatile("" ::: "memory"); }
        return tag == 2;
    }
};
struct EpiWout {
    const float* x; h16* X1h; float* SSQ;
    __device__ __forceinline__ bool operator()(AccT& acc, const pg8::Unit& u, int wr, int wc, int fr, int fq) const {
        EPI_ROWS(u);
#pragma unroll
        for (int ai = 0; ai < 2; ++ai) {
            f32x4 xv[4][2][2];
#pragma unroll
            for (int m = 0; m < 4; ++m)
#pragma unroll
                for (int bj = 0; bj < 2; ++bj) { const size_t o = (size_t)(row0 + ai * 128 + m * 16) * DM + u.pn * 256 + cw0 + bj * 128;
                    xv[m][bj][0] = __builtin_nontemporal_load((const f32x4*)(x + o)); xv[m][bj][1] = __builtin_nontemporal_load((const f32x4*)(x + o + 4)); }
#pragma unroll
            for (int m = 0; m < 4; ++m) { const size_t row = (size_t)(row0 + ai * 128 + m * 16); float ss = 0.f;
#pragma unroll
                for (int bj = 0; bj < 2; ++bj) { const size_t o = row * DM + u.pn * 256 + cw0 + bj * 128;
                    const f32x4 a = acc[ai][bj][m][0] + xv[m][bj][0], b = acc[ai][bj][m][1] + xv[m][bj][1];
                    *(u32x4*)(X1h + o) = pack8(a, b);
                    ss += (a[0] * a[0] + a[1] * a[1]) + (a[2] * a[2] + a[3] * a[3]) + (b[0] * b[0] + b[1] * b[1]) + (b[2] * b[2] + b[3] * b[3]); }
                ss += __shfl_xor(ss, 16); ss += __shfl_xor(ss, 32);
                if (fq == 0) SSQ[row * 16 + u.pn * 4 + wc] = ss; }
            asm volatile("" ::: "memory"); }
        return false;
    }
};
struct EpiFfnIn {
    const LAS float* rtab; h16* HID;
    __device__ __forceinline__ bool operator()(AccT& acc, const pg8::Unit& u, int wr, int wc, int fr, int fq) const {
        EPI_ROWS(u);
        EPI_FOR { const size_t row = (size_t)(row0 + ai * 128 + m * 16);
            const float rstd = rtab[u.tag * 256 + wr * 64 + fr + ai * 128 + m * 16];
            f32x4 a, b;
#pragma unroll
            for (int j = 0; j < 4; ++j) { const float g0 = acc[ai][0][m][0][j] * rstd, g1 = acc[ai][0][m][1][j] * rstd;
                a[j] = g0 * sigmoidf_(g0) * (acc[ai][1][m][0][j] * rstd); b[j] = g1 * sigmoidf_(g1) * (acc[ai][1][m][1][j] * rstd); }
            *(u32x4*)(HID + row * FF + u.pn * 128 + cw0) = pack8(a, b);
            asm volatile("" ::: "memory"); }
        return false;
    }
};
struct EpiFfnOut {
    const h16* X1h; const float* gain; float* out; float* SSQ2; unsigned* cnt; LAS float* rt;
    __device__ __forceinline__ bool operator()(AccT& acc, const pg8::Unit& u, int wr, int wc, int fr, int fq) const {
        EPI_ROWS(u);
        h16x8 xhv[2][4][2];
        EPI_FOR { const size_t row = (size_t)(row0 + ai * 128 + m * 16);
#pragma unroll
            for (int bj = 0; bj < 2; ++bj) xhv[ai][m][bj] = *(const h16x8*)(X1h + row * DM + u.pn * 256 + cw0 + bj * 128); }
        EPI_FOR { const size_t row = (size_t)(row0 + ai * 128 + m * 16); float ss = 0.f;
#pragma unroll
            for (int bj = 0; bj < 2; ++bj) { const h16x8 xh = xhv[ai][m][bj];
                f32x4 a = acc[ai][bj][m][0], b = acc[ai][bj][m][1];
#pragma unroll
                for (int j = 0; j < 4; ++j) { a[j] += (float)xh[j]; b[j] += (float)xh[4 + j]; }
                acc[ai][bj][m][0] = a; acc[ai][bj][m][1] = b;
                ss += (a[0] * a[0] + a[1] * a[1]) + (a[2] * a[2] + a[3] * a[3]) + (b[0] * b[0] + b[1] * b[1]) + (b[2] * b[2] + b[3] * b[3]); }
            ss += __shfl_xor(ss, 16); ss += __shfl_xor(ss, 32);
            if (fq == 0) __hip_atomic_store(SSQ2 + row * 16 + u.pn * 4 + wc, ss, __ATOMIC_RELAXED, __HIP_MEMORY_SCOPE_AGENT);
        }
        asm volatile("s_waitcnt vmcnt(0)" ::: "memory");
        unsigned* cw = cnt + 64 * u.pm;
        if ((threadIdx.x & 63) == 0) __hip_atomic_fetch_add(cw, 1u, __ATOMIC_RELAXED, __HIP_MEMORY_SCOPE_AGENT);
        if (threadIdx.x < 64) {
            unsigned spins = 0;
            while ((unsigned)__builtin_amdgcn_readfirstlane(__hip_atomic_load(cw, __ATOMIC_RELAXED, __HIP_MEMORY_SCOPE_AGENT)) < 32u) { __builtin_amdgcn_s_sleep(2); if (++spins > (1u << 22)) break; }
            __builtin_amdgcn_fence(__ATOMIC_ACQUIRE, "agent");
            asm volatile("s_waitcnt vmcnt(0)" ::: "memory");
        }
        asm volatile("" ::: "memory"); __builtin_amdgcn_s_barrier(); asm volatile("" ::: "memory");
        { const int lane = threadIdx.x & 63, rr = (wr * 4 + wc) * 32 + (lane & 31); const float* sl = SSQ2 + ((size_t)u.pm * 256 + rr) * 16 + 8 * (lane >> 5);
          float tot = 0.f;
#pragma unroll
          for (int i = 0; i < 8; ++i) tot += __hip_atomic_load(sl + i, __ATOMIC_RELAXED, __HIP_MEMORY_SCOPE_AGENT);
          tot += __shfl_xor(tot, 32);
          if (lane < 32) rt[rr] = rsqrtf(tot * (1.f / DM) + EPS); }
        asm volatile("s_waitcnt lgkmcnt(0)" ::: "memory"); __builtin_amdgcn_s_barrier(); asm volatile("" ::: "memory");
        f32x4 gv[2][2];
#pragma unroll
        for (int bj = 0; bj < 2; ++bj) { const int col = u.pn * 256 + cw0 + bj * 128; gv[bj][0] = *(const f32x4*)(gain + col); gv[bj][1] = *(const f32x4*)(gain + col + 4); }
        EPI_FOR { const size_t row = (size_t)(row0 + ai * 128 + m * 16);
            const float rstd = rt[ai * 128 + wr * 64 + m * 16 + fr];
#pragma unroll
            for (int bj = 0; bj < 2; ++bj) { const size_t o = row * DM + u.pn * 256 + cw0 + bj * 128;
                __builtin_nontemporal_store(acc[ai][bj][m][0] * rstd * gv[bj][0], (f32x4*)(out + o)); __builtin_nontemporal_store(acc[ai][bj][m][1] * rstd * gv[bj][1], (f32x4*)(out + o + 4)); } }
        return false;
    }
};

constexpr int S5T = 32, S5K = 640, S5ROWS = 512;
__device__ __forceinline__ void s5_prep_part(const CAS Params& p, int g, int part, h16* BtMain, h16* BtSt, LAS unsigned char* lds) {
    LAS float* lp = (LAS float*)lds;
    LAS float* G0 = lp + 33 * 128;
    LAS float* Cc = G0 + 2048;
    LAS float* Kt = Cc + 2048;
    int tid_ = threadIdx.x; asm volatile("" : "+v"(tid_));
    const int tid = tid_;
    __syncthreads();
    if (tid < NP) {
        const int pp = tid;
        const float dt = __expf(p.log_dt[g]);
        const float ar = p.a_re[g * NP + pp], ai = p.a_im[g * NP + pp];
        const float mag = __expf(ar * dt);
        float s, c; sincos_big(ai * dt, s, c);
        const float lbr = mag * c, lbi = mag * s;
        const float nr = lbr - 1.f, ni = lbi, den = ar * ar + ai * ai;
        const float fr = (nr * ar + ni * ai) / den, fi = (ni * ar - nr * ai) / den;
        float cr = 1.f, ci = 0.f;
        for (int d = 0; d <= S5T; ++d) { lp[(d * 2) * 64 + pp] = cr; lp[(d * 2 + 1) * 64 + pp] = ci; const float t = cr * lbr - ci * lbi; ci = cr * lbi + ci * lbr; cr = t; }
        for (int c2 = 0; c2 < GC; ++c2) { const float br = p.b_re[((size_t)g * NP + pp) * GC + c2], bi = p.b_im[((size_t)g * NP + pp) * GC + c2];
            G0[(pp * 16 + c2) * 2] = fr * br - fi * bi; G0[(pp * 16 + c2) * 2 + 1] = fr * bi + fi * br; }
    }
    for (int i = tid; i < GC * NP; i += 512) { Cc[2 * i] = p.c_re[(size_t)g * GC * NP + i]; Cc[2 * i + 1] = p.c_im[(size_t)g * GC * NP + i]; }
    __syncthreads();
    { const int c = (tid >> 4) & 15, c1 = tid & 15, dh = tid >> 8;
      const float dsk = p.d_skip[g * GC + c];
      float accd[16];
#pragma unroll
      for (int dd = 0; dd < 16; ++dd) accd[dd] = 0.f;
#pragma unroll
      for (int h = 0; h < 2; ++h) {
          f32x4 wr4[8], wi4[8];
#pragma unroll
          for (int q = 0; q < 8; ++q)
#pragma unroll
              for (int e = 0; e < 4; ++e) { const int pp = 32 * h + 4 * q + e; const float cr = Cc[(c * 64 + pp) * 2], ci = Cc[(c * 64 + pp) * 2 + 1], gr = G0[(pp * 16 + c1) * 2], gi = G0[(pp * 16 + c1) * 2 + 1];
                  wr4[q][e] = cr * gr - ci * gi; wi4[q][e] = -(cr * gi + ci * gr); }
#pragma unroll
          for (int dd = 0; dd < 16; ++dd) { const int d = dh * 16 + dd;
              const LAS f32x4* lr4 = (const LAS f32x4*)(lp + (d * 2) * 64) + 8 * h; const LAS f32x4* li4 = (const LAS f32x4*)(lp + (d * 2 + 1) * 64) + 8 * h;
              f32x4 s0 = (f32x4){0.f, 0.f, 0.f, 0.f}, s1 = s0, s2 = s0, s3 = s0;
#pragma unroll
              for (int q = 0; q < 8; q += 2) { s0 += lr4[q] * wr4[q]; s1 += li4[q] * wi4[q]; s2 += lr4[q + 1] * wr4[q + 1]; s3 += li4[q + 1] * wi4[q + 1]; }
              const f32x4 s = (s0 + s1) + (s2 + s3);
              accd[dd] += (s[0] + s[1]) + (s[2] + s[3]);
              asm volatile("" ::: "memory"); }
      }
#pragma unroll
      for (int dd = 0; dd < 16; ++dd) { const int d = dh * 16 + dd; Kt[(d * 16 + c) * 16 + c1] = accd[dd] + ((d == 0 && c == c1) ? dsk : 0.f); } }
    __syncthreads();
    h16* bm = BtMain + (size_t)g * S5ROWS * S5K;
    for (int pc = tid; pc < 128 * 80; pc += 512) {
        const int n = part * 128 + pc / 80, k8 = (pc % 80) * 8, tau = n >> 4, c = n & 15;
        float v[8];
        if (k8 < 512) { const int sg = k8 >> 4, c0 = k8 & 15;
#pragma unroll
            for (int j = 0; j < 8; ++j) v[j] = sg <= tau ? Kt[((tau - sg) * 16 + c) * 16 + c0 + j] : 0.f;
        } else { const int q0 = k8 - 512; const bool im = q0 >= 64; const int p0 = q0 & 63;
#pragma unroll
            for (int j = 0; j < 8; ++j) { const int pp = p0 + j; const float cr = Cc[(c * 64 + pp) * 2], ci = Cc[(c * 64 + pp) * 2 + 1], lr = lp[((tau + 1) * 2) * 64 + pp], li = lp[((tau + 1) * 2 + 1) * 64 + pp];
                v[j] = im ? -(cr * li + ci * lr) : (cr * lr - ci * li); }
        }
        u32x4 o; o.x = pk2h(v[0], v[1]); o.y = pk2h(v[2], v[3]); o.z = pk2h(v[4], v[5]); o.w = pk2h(v[6], v[7]);
        *(u32x4*)(bm + (size_t)n * S5K + k8) = o;
    }
    h16* bs = BtSt + (size_t)g * 256 * 512;
    if (part < 2) for (int pc = tid; pc < 64 * 64; pc += 512) {
        const int n = part * 64 + (pc >> 6), k8 = (pc & 63) * 8, sg = k8 >> 4, c0 = k8 & 15;
        float v[8];
        if (n < 128) { const int pp = n & 63; const bool im = n >= 64; const float lr = lp[((S5T - 1 - sg) * 2) * 64 + pp], li = lp[((S5T - 1 - sg) * 2 + 1) * 64 + pp];
#pragma unroll
            for (int j = 0; j < 8; ++j) { const float gr = G0[(pp * 16 + c0 + j) * 2], gi = G0[(pp * 16 + c0 + j) * 2 + 1]; v[j] = im ? (lr * gi + li * gr) : (lr * gr - li * gi); }
        } else {
#pragma unroll
            for (int j = 0; j < 8; ++j) v[j] = 0.f;
        }
        u32x4 o; o.x = pk2h(v[0], v[1]); o.y = pk2h(v[2], v[3]); o.z = pk2h(v[4], v[5]); o.w = pk2h(v[6], v[7]);
        *(u32x4*)(bs + (size_t)n * 512 + k8) = o;
    }
    __syncthreads();
}
__device__ __forceinline__ void s5_scan_one(const CAS Params& p, const float* Sbuf, h16* Up, LAS unsigned char* lds, int b, int g) {
    int tid_ = threadIdx.x; asm volatile("" : "+v"(tid_));
    const int lane = tid_ & 63, seg = tid_ >> 6;
    LAS float* ex = (LAS float*)lds;
    const float dt = __expf(p.log_dt[g]);
    const float ar = p.a_re[g * NP + lane], ai = p.a_im[g * NP + lane];
    const float mag = __expf(ar * dt);
    float s, c; sincos_big(ai * dt, s, c);
    float lr = mag * c, li = mag * s;
#pragma unroll
    for (int i = 0; i < 5; ++i) { const float t = lr * lr - li * li; li = 2.f * lr * li; lr = t; }
    float Lr = lr, Li = li;
#pragma unroll
    for (int i = 0; i < 5; ++i) { const float t = Lr * Lr - Li * Li; Li = 2.f * Lr * Li; Lr = t; }
    const float* sp = Sbuf + ((size_t)g * S5ROWS + (size_t)b * 256 + seg * 32) * 128 + lane;
    h16* hp = Up + ((size_t)g * S5ROWS + (size_t)b * 256 + seg * 32) * S5K + 512 + lane;
    float hr = 0.f, hi = 0.f;
    for (int k0 = 0; k0 < 32; k0 += 16) {
        float sr[16], si[16];
#pragma unroll
        for (int j = 0; j < 16; ++j) { sr[j] = sp[(size_t)(k0 + j) * 128]; si[j] = sp[(size_t)(k0 + j) * 128 + 64]; }
#pragma unroll
        for (int j = 0; j < 16; ++j) { const float nr = lr * hr - li * hi + sr[j], ni = lr * hi + li * hr + si[j]; hr = nr; hi = ni; }
    }
    __syncthreads();
    ex[(seg * 64 + lane) * 2] = hr; ex[(seg * 64 + lane) * 2 + 1] = hi;
    __syncthreads();
    hr = 0.f; hi = 0.f;
    for (int s2 = 0; s2 < seg; ++s2) { const float er = ex[(s2 * 64 + lane) * 2], ei = ex[(s2 * 64 + lane) * 2 + 1];
        const float nr = Lr * hr - Li * hi + er, ni = Lr * hi + Li * hr + ei; hr = nr; hi = ni; }
    for (int k0 = 0; k0 < 32; k0 += 16) {
        float sr[16], si[16];
#pragma unroll
        for (int j = 0; j < 16; ++j) { sr[j] = sp[(size_t)(k0 + j) * 128]; si[j] = sp[(size_t)(k0 + j) * 128 + 64]; }
#pragma unroll
        for (int j = 0; j < 16; ++j) {
            hp[(size_t)(k0 + j) * S5K] = (h16)hr; hp[(size_t)(k0 + j) * S5K + 64] = (h16)hi;
            const float nr = lr * hr - li * hi + sr[j], ni = lr * hi + li * hr + si[j]; hr = nr; hi = ni;
        }
    }
    __syncthreads();
}
struct SchedOne { bool ok; const char* A; const char* B; int pm, pn, tag;
    __device__ __forceinline__ bool next(int i, pg8::Unit& u) const { if (!ok || i != 0) return false; u.A = A; u.B = B; u.pm = pm; u.pn = pn; u.tag = tag; return true; } };
struct EpiS5State {
    float* Sbuf;
    __device__ __forceinline__ bool operator()(AccT& acc, const pg8::Unit& u, int wr, int wc, int fr, int fq) const {
        EPI_ROWS(u);
        EPI_FOR { float* sp = Sbuf + ((size_t)u.tag * S5ROWS + (size_t)(row0 + ai * 128 + m * 16)) * 128 + cw0; *(f32x4*)sp = acc[ai][0][m][0]; *(f32x4*)(sp + 4) = acc[ai][0][m][1]; }
        return false;
    }
};
struct EpiS5Main {
    h16* YS;
    __device__ __forceinline__ bool operator()(AccT& acc, const pg8::Unit& u, int wr, int wc, int fr, int fq) const {
        EPI_ROWS(u);
        EPI_FOR { const int row = row0 + ai * 128 + m * 16; const size_t tok0 = (size_t)(row >> 8) * SEQ + (size_t)(row & 255) * S5T;
#pragma unroll
            for (int bj = 0; bj < 2; ++bj) { const int n = u.pn * 256 + cw0 + bj * 128, tau = n >> 4, c = n & 15;
                f32x4 a = acc[ai][bj][m][0], b = acc[ai][bj][m][1];
#pragma unroll
                for (int j = 0; j < 4; ++j) { a[j] = gelu_tanh(a[j]); b[j] = gelu_tanh(b[j]); }
                *(u32x4*)(YS + (tok0 + tau) * DM + u.tag * GC + c) = pack8(a, b); } }
        return false;
    }
};

template <bool STREAM = false>
__device__ __forceinline__ void tr_item(const float* __restrict__ W, int ldw, int c0, int ncols, int K, h16* WT, int r0, const float* kscale, LAS float* scr, int item, int lane) {
    const int nblk = (ncols + 31) >> 5, kb = item / nblk, nb = item % nblk, k0 = 64 * kb, n0 = 32 * nb;
    const int cq = 4 * (lane & 7), nn = n0 + cq;
    f32x4 v[8];
#pragma unroll
    for (int i = 0; i < 8; ++i) { const int kk = 8 * i + (lane >> 3); v[i] = nn < ncols ? __builtin_nontemporal_load((const f32x4*)(W + (size_t)(k0 + kk) * ldw + c0 + nn)) : (f32x4){0.f, 0.f, 0.f, 0.f}; }
#pragma unroll
    for (int i = 0; i < 8; ++i) { const int kk = 8 * i + (lane >> 3); f32x4 x = v[i]; if (kscale) x = x * kscale[k0 + kk];
        scr[kk * 33 + cq] = x[0]; scr[kk * 33 + cq + 1] = x[1]; scr[kk * 33 + cq + 2] = x[2]; scr[kk * 33 + cq + 3] = x[3]; }
    asm volatile("s_waitcnt lgkmcnt(0)" ::: "memory");
    const int c = lane & 7;
#pragma unroll
    for (int j = 0; j < 4; ++j) { const int n = (lane >> 3) + 8 * j; const LAS float* s = scr + (8 * c) * 33 + n;
        u32x4 o; o.x = pk2h(s[0 * 33], s[1 * 33]); o.y = pk2h(s[2 * 33], s[3 * 33]); o.z = pk2h(s[4 * 33], s[5 * 33]); o.w = pk2h(s[6 * 33], s[7 * 33]);
        if (STREAM) __builtin_nontemporal_store(o, (u32x4*)(WT + (size_t)(r0 + n0 + n) * K + k0 + 8 * c)); else *(u32x4*)(WT + (size_t)(r0 + n0 + n) * K + k0 + 8 * c) = o; }
    asm volatile("s_waitcnt lgkmcnt(0)" ::: "memory");
}
__device__ __forceinline__ void prologue_weights(const CAS Params& p, unsigned char* ws, LAS unsigned char* lds, int part, int gw, int NGW, int lo = 0, int hi = 1 << 30) {
    int tid_ = threadIdx.x; asm volatile("" : "+v"(tid_));
    const int lane = tid_ & 63, wv = __builtin_amdgcn_readfirstlane(tid_ >> 6);
    LAS float* scr = (LAS float*)(lds + wv * 16384);
    h16* Win = (h16*)(ws + WS_WIN); h16* Wga = (h16*)(ws + WS_WGA); h16* Wgb = (h16*)(ws + WS_WGB); h16* Wglu = (h16*)(ws + WS_WGLU);
    h16* Wa = (h16*)(ws + WS_WA); h16* Wb = (h16*)(ws + WS_WB); h16* Wout = (h16*)(ws + WS_WOUT); h16* Wfi = (h16*)(ws + WS_WFI); h16* Wfo = (h16*)(ws + WS_WFO);
    constexpr int I_IN = 16 * 115, I_SQ = 16 * 32, I_FI = 44 * 64, I_FO = 44 * 32;
    if (part == 0) { for (int it = gw; it < I_IN; it += NGW) tr_item(p.w_in, INW, 0, C_GA, DM, Win, 0, nullptr, scr, it, lane); return; }
    constexpr int NITEMS = 6 * I_SQ + I_FI + I_FO;
    const int iend = hi < NITEMS ? hi : NITEMS;
    for (int it = lo + gw; it < iend; it += NGW) {
        int r = it;
        if (r < I_SQ) { tr_item<true>(p.w_in, INW, C_GA, DM, DM, Wga, 0, nullptr, scr, r, lane); continue; } r -= I_SQ;
        if (r < I_SQ) { tr_item<true>(p.w_in, INW, C_GB, DM, DM, Wgb, 0, nullptr, scr, r, lane); continue; } r -= I_SQ;
        if (r < I_SQ) { tr_item<true>(p.w_glu, DM, 0, DM, DM, Wglu, 0, nullptr, scr, r, lane); continue; } r -= I_SQ;
        if (r < I_SQ) { tr_item<true>(p.w_a, DM, 0, DM, DM, Wa, 0, nullptr, scr, r, lane); continue; } r -= I_SQ;
        if (r < I_SQ) { tr_item<true>(p.w_b, DM, 0, DM, DM, Wb, 0, nullptr, scr, r, lane); continue; } r -= I_SQ;
        if (r < I_SQ) { tr_item<true>(p.w_out, DM, 0, DM, DM, Wout, 0, nullptr, scr, r, lane); continue; } r -= I_SQ;
        if (r < I_FI) { const int sub = r >> 6, j = sub >> 1, hf = sub & 1; tr_item<true>(p.w_ffn_in, 2 * FF, hf * FF + j * 128, 128, DM, Wfi, j * 256 + hf * 128, p.norm2_g, scr, r & 63, lane); continue; } r -= I_FI;
        tr_item<true>(p.w_ffn_out, DM, 0, DM, FF, Wfo, 0, nullptr, scr, r, lane);
    }
}

__device__ __forceinline__ int wave_id_() { int t = threadIdx.x; asm volatile("" : "+v"(t)); return t >> 6; }
__device__ __forceinline__ unsigned char* ws_opq_(unsigned char* w) { unsigned long long u = (unsigned long long)w; asm volatile("" : "+s"(u)); return (unsigned char*)(__attribute__((address_space(1))) unsigned char*)u; }
__global__ void __launch_bounds__(512, 2) mk_fwd(Params p_) {
    (void)p_;
    const CAS Params& p = *(const CAS Params*)__builtin_amdgcn_kernarg_segment_ptr();
    extern __shared__ __attribute__((aligned(16))) unsigned char lds_raw[];
    LAS unsigned char* lds = (LAS unsigned char*)lds_raw;
    float* sm = (float*)lds_raw;
    unsigned char* ws = p.ws;
#define WSO_ ws_opq_(ws)
    const int G = gridDim.x, bx = blockIdx.x;
    { volatile LAS unsigned* st0 = (volatile LAS unsigned*)(lds + LDS_BYTES - 64); if (threadIdx.x < 16) st0[threadIdx.x] = 0u; }
    __syncthreads();
    const XcdBarrier xbar = xcd_barrier_post((unsigned*)(ws + WS_CTL) + 4096, (volatile LAS unsigned*)(lds + LDS_BYTES - 64));

    if (((bx >> 3) & 1) == 0) {
        for (int v = bx; v < 4 * NG; v += G) s5_prep_part(p, v >> 2, v & 3, (h16*)(ws + WS_BTM), (h16*)(ws + WS_BTS), lds);
        prologue_weights(p, ws, lds, 0, bx * 8 + wave_id_(), G * 8);
        rmsnorm_rows_h16(p.x, p.norm1_g, ((h16*)(WSO_ + WS_H)));
    } else {
        rmsnorm_rows_h16(p.x, p.norm1_g, ((h16*)(WSO_ + WS_H)));
        prologue_weights(p, ws, lds, 0, bx * 8 + wave_id_(), G * 8);
        for (int v = bx; v < 4 * NG; v += G) s5_prep_part(p, v >> 2, v & 3, (h16*)(ws + WS_BTM), (h16*)(ws + WS_BTS), lds);
    }
    xcd_barrier(xbar);
    { pg8::SchedStd S; S.so.init(M, NWIN, G, bx); S.A = (const char*)((h16*)(WSO_ + WS_H)); S.B = ((const char*)(WSO_ + WS_WIN)); S.tstepA = (size_t)256 * DM * 2; S.tstepB = (size_t)256 * DM * 2;
      pg8::gemm_phase(lds, pg8::Geo{DM, DM, DM / 64}, S, EpiInProj{((h16*)(WSO_ + WS_U)), ((h16*)p.out), ((h16*)(WSO_ + WS_K)), ((h16*)(WSO_ + WS_V)), ((h16*)(WSO_ + WS_QI)), ((h16*)(WSO_ + WS_KI)), ((float*)(WSO_ + WS_WI))}); }
    if (G == 256 && bx >= 192) prologue_weights(p, ws, lds, 1, (bx - 192) * 8 + wave_id_(), 64 * 8, 0, 3072);
    xcd_barrier(xbar);
    { float* Sbuf = (float*)((unsigned char*)p.out + 32 * MiB);
      if (G == 256) {
        const int xl = bx & 7, l = bx >> 3; const bool first = l < 16; const int s = xl * 16 + (l & 15), g = s >> 1, rt = s & 1;
        unsigned* flag = (unsigned*)(ws + WS_CTL) + 12288 + s;
        if (first) {
            { SchedOne S; S.ok = true; S.A = (const char*)((h16*)(WSO_ + WS_U)) + ((size_t)g * 512 + rt * 256) * 640 * 2; S.B = (const char*)(ws + WS_BTS) + (size_t)g * 256 * 512 * 2; S.pm = rt; S.pn = 0; S.tag = g;
              pg8::gemm_phase(lds, pg8::Geo{640, 512, 8}, S, EpiS5State{Sbuf}); }
            s5_scan_one(p, Sbuf, ((h16*)(WSO_ + WS_U)), lds, rt, g);
            asm volatile("s_waitcnt vmcnt(0)" ::: "memory");
            __syncthreads();
            if (threadIdx.x == 0) { __builtin_amdgcn_fence(__ATOMIC_RELEASE, "agent"); __hip_atomic_store(flag, 1u, __ATOMIC_RELAXED, __HIP_MEMORY_SCOPE_AGENT); __builtin_amdgcn_fence(__ATOMIC_ACQUIRE, "agent"); }
            __syncthreads();
        } else {
            prologue_weights(p, ws, lds, 1, (xl * 16 + (l - 16)) * 8 + wave_id_(), 128 * 8, 3072);
            if (threadIdx.x == 0) { unsigned sp = 0; while (__hip_atomic_load(flag, __ATOMIC_RELAXED, __HIP_MEMORY_SCOPE_AGENT) == 0u) { __builtin_amdgcn_s_sleep(2); if (++sp > (1u << 22)) break; }
                __builtin_amdgcn_fence(__ATOMIC_ACQUIRE, "agent"); asm volatile("s_waitcnt vmcnt(0)" ::: "memory"); }
            __syncthreads();
        }
        { SchedOne S; S.ok = true; const int pn = first ? 0 : 1; S.A = (const char*)((h16*)(WSO_ + WS_U)) + ((size_t)g * 512 + rt * 256) * 640 * 2; S.B = (const char*)(ws + WS_BTM) + ((size_t)g * 512 + pn * 256) * 640 * 2; S.pm = rt; S.pn = pn; S.tag = g;
          pg8::gemm_phase(lds, pg8::Geo{640, 640, 10}, S, EpiS5Main{((h16*)(WSO_ + WS_YS))}); }
      } else {
      const int vb = bx;
      { SchedOne S; S.ok = vb < 128; const int g = vb >> 1, rt = vb & 1; S.A = (const char*)((h16*)(WSO_ + WS_U)) + ((size_t)g * 512 + rt * 256) * 640 * 2; S.B = (const char*)(ws + WS_BTS) + (size_t)g * 256 * 512 * 2; S.pm = rt; S.pn = 0; S.tag = g;
        pg8::gemm_phase(lds, pg8::Geo{640, 512, 8}, S, EpiS5State{Sbuf}); }
      if (vb < 128) s5_scan_one(p, Sbuf, ((h16*)(WSO_ + WS_U)), lds, vb & 1, vb >> 1);
      else prologue_weights(p, ws, lds, 1, (vb - 128) * 8 + wave_id_(), (G - 128) * 8, 0);
      xcd_barrier(xbar);
      { SchedOne S; S.ok = vb < 256; const int g = vb >> 2, rt = (vb >> 1) & 1, pn = vb & 1; S.A = (const char*)((h16*)(WSO_ + WS_U)) + ((size_t)g * 512 + rt * 256) * 640 * 2; S.B = (const char*)(ws + WS_BTM) + ((size_t)g * 512 + pn * 256) * 640 * 2; S.pm = rt; S.pn = pn; S.tag = g;
        pg8::gemm_phase(lds, pg8::Geo{640, 640, 10}, S, EpiS5Main{((h16*)(WSO_ + WS_YS))}); }
      } }
    xcd_barrier(xbar);
    { pg8::SchedStd S; S.so.init(M, DM, G, bx); S.A = (const char*)((h16*)(WSO_ + WS_YS)); S.B = ((const char*)(WSO_ + WS_WGLU)); S.tstepA = (size_t)256 * DM * 2; S.tstepB = (size_t)256 * DM * 2;
      pg8::gemm_phase(lds, pg8::Geo{DM, DM, DM / 64}, S, EpiGlu{((h16*)(WSO_ + WS_YS)), ((h16*)((unsigned char*)p.out + 32 * MiB))}); }
    xcd_barrier(xbar);
    scores_phase(((h16*)(WSO_ + WS_QI)), ((h16*)(WSO_ + WS_KI)), ((float*)(WSO_ + WS_WI)), ((h16*)(WSO_ + WS_SC)), lds);
    xcd_barrier(xbar);
    select_phase2(((h16*)(WSO_ + WS_SC)), ((unsigned short*)(WSO_ + WS_IDX)), lds);
    xcd_barrier(xbar);
    attn_phase(((h16*)p.out), ((h16*)(WSO_ + WS_K)), ((h16*)(WSO_ + WS_V)), ((unsigned short*)(WSO_ + WS_IDX)), ((h16*)(WSO_ + WS_YB)), lds);
    xcd_barrier(xbar);
    { pg8::StaticOrder so; so.init(M, DM, G, bx); int pm = 0, pn = 0; const bool ok = so.next(0, pm, pn);
      const size_t ta = (size_t)pm * 256 * DM * 2, tb = (size_t)pn * 256 * DM * 2;
      pg8::SchedSeg4 S; S.pm = pm; S.pn = pn; S.ok = ok; S.aH = (const char*)((h16*)(WSO_ + WS_H)) + ta; S.dYA = (const char*)((h16*)((unsigned char*)p.out + 32 * MiB)) - (const char*)((h16*)(WSO_ + WS_H)); S.dYB = (const char*)((h16*)(WSO_ + WS_YB)) - (const char*)((h16*)(WSO_ + WS_H)); S.bW = ((const char*)(WSO_ + WS_WGA)) + tb; S.bstep = (long)(2 * MiB);
      pg8::gemm_phase(lds, pg8::Geo{DM, DM, DM / 64}, S, EpiMerge{((h16*)(WSO_ + WS_SA)), ((h16*)(WSO_ + WS_SB)), ((h16*)(WSO_ + WS_MG))}); }
    xcd_barrier(xbar);
    { pg8::SchedStd S; S.so.init(M, DM, G, bx); S.A = (const char*)((h16*)(WSO_ + WS_MG)); S.B = ((const char*)(WSO_ + WS_WOUT)); S.tstepA = (size_t)256 * DM * 2; S.tstepB = (size_t)256 * DM * 2;
      pg8::gemm_phase(lds, pg8::Geo{DM, DM, DM / 64}, S, EpiWout{p.x, ((h16*)(WSO_ + WS_H)), ((float*)(WSO_ + WS_SSQ))}); }
    xcd_barrier(xbar);
    { pg8::SchedStd S; S.so.init(M, 2 * FF, G, bx); S.A = (const char*)((h16*)(WSO_ + WS_H)); S.B = ((const char*)(WSO_ + WS_WFI)); S.tstepA = (size_t)256 * DM * 2; S.tstepB = (size_t)256 * DM * 2;
      LAS float* rtab = (LAS float*)(lds + 131072);
      { int tid2 = threadIdx.x; asm volatile("" : "+v"(tid2));
        for (int e = tid2; e < 8 * 256; e += 512) { const int ui = e >> 8, r = e & 255; int pm, pn;
            if (S.so.next(ui, pm, pn)) { const float* sq = ((float*)(WSO_ + WS_SSQ)) + ((size_t)pm * 256 + r) * 16;
                const f32x4 s0 = *(const f32x4*)sq, s1 = *(const f32x4*)(sq + 4), s2 = *(const f32x4*)(sq + 8), s3 = *(const f32x4*)(sq + 12); const f32x4 st = (s0 + s1) + (s2 + s3);
                rtab[e] = rsqrtf(((st[0] + st[1]) + (st[2] + st[3])) * (1.f / DM) + EPS); } }
        __syncthreads(); }
      pg8::gemm_phase(lds, pg8::Geo{DM, DM, DM / 64}, S, EpiFfnIn{rtab, ((h16*)(WSO_ + WS_HID))}); }
    xcd_barrier(xbar);
    { pg8::SchedStd S; S.so.init(M, DM, G, bx); S.A = (const char*)((h16*)(WSO_ + WS_HID)); S.B = ((const char*)(WSO_ + WS_WFO)); S.tstepA = (size_t)256 * FF * 2; S.tstepB = (size_t)256 * FF * 2;
      pg8::gemm_phase(lds, pg8::Geo{FF, FF, FF / 64}, S, EpiFfnOut{((h16*)(WSO_ + WS_H)), p.norm_f_g, p.out, ((float*)(WSO_ + WS_SSQ)) + (size_t)M * 16, (unsigned*)(ws + WS_CTL) + 8192, (LAS float*)(lds + 131072)}); }
}

extern "C" void kernel_launch(void* const* d_in, const int* in_sizes, int n_in, void* d_out, int out_size, void* d_ws, size_t ws_size, hipStream_t stream) {
    static int grid = 0;
    if (grid == 0) {
        int dev = 0, cus = 0, per_cu = 0;
        (void)hipGetDevice(&dev);
        (void)hipDeviceGetAttribute(&cus, hipDeviceAttributeMultiprocessorCount, dev);
        if (hipFuncSetAttribute((const void*)mk_fwd, hipFuncAttributeMaxDynamicSharedMemorySize, LDS_BYTES) != hipSuccess) fprintf(stderr, "kernel_launch: hipFuncSetAttribute failed\n");
        if (hipOccupancyMaxActiveBlocksPerMultiprocessor(&per_cu, (const void*)mk_fwd, 512, LDS_BYTES) != hipSuccess || per_cu < 1) { fprintf(stderr, "kernel_launch: occupancy query says %d\n", per_cu); per_cu = 1; }
        (void)hipGetLastError();
        grid = cus;
        if (ws_size < WS_END) fprintf(stderr, "kernel_launch: workspace too small: %zu < %zu\n", ws_size, (size_t)WS_END);
    }
    (void)hipMemsetAsync((char*)d_ws + WS_CTL, 0, 65536, stream);
    Params p{};
    const float** f = (const float**)&p;
    for (int i = 0; i < 19; ++i) f[i] = (const float*)d_in[i];
    p.out = (float*)d_out; p.ws = (unsigned char*)d_ws;
    void* args[] = {&p};
    hipError_t e = hipLaunchCooperativeKernel((const void*)mk_fwd, dim3(grid), dim3(512), args, LDS_BYTES, stream);
    if (e != hipSuccess) {
        fprintf(stderr, "cooperative launch failed: %s (grid %d); launching the same grid plainly\n", hipGetErrorString(e), grid);
        (void)hipGetLastError();
        hipLaunchKernelGGL(mk_fwd, dim3(grid), dim3(512), LDS_BYTES, stream, p);
    }
}
```
